# Optimizing an MI355X kernel written in HIP

```python
import math
import jax, jax.numpy as jnp
from jax import lax
import numpy as np

D_MODEL = 2048
BATCH = 4
SEQ = 2048
DEPTH = 1

HEAD_DIM = 128
Q_BLOCK = 128
NSA_HEADS = 8
NSA_KV_GROUPS = 2
NSA_HPG = NSA_HEADS // NSA_KV_GROUPS
CMP_LEN = 32
CMP_STRIDE = 16
SEL_BLOCK = 64
N_SEL = 16
WINDOW = 512
SEL_Q_CHUNK = 64
N_NSA_BRANCH = 3
DIFF_HEADS = 4
DIFF_V_DIM = 2 * HEAD_DIM
NUM_BUCKETS = 32
MAX_DISTANCE = 128
N_BIAS_HEADS = NSA_HEADS + DIFF_HEADS
D_FF = 5632
CONV_WIDTH = 3
N_BRANCHES = 2
EPS = 1e-6
NEG = -1e30

NSA_Q_COLS = NSA_HEADS * HEAD_DIM
NSA_KV_COLS = N_NSA_BRANCH * 2 * NSA_KV_GROUPS * HEAD_DIM
NSA_GATE_COLS = NSA_HEADS * N_NSA_BRANCH
DIFF_Q_COLS = DIFF_HEADS * 2 * HEAD_DIM
DIFF_K_COLS = DIFF_HEADS * 2 * HEAD_DIM
DIFF_V_COLS = DIFF_HEADS * DIFF_V_DIM
MERGE_GATE_COLS = N_BRANCHES * D_MODEL
OFF_NSA_KV = NSA_Q_COLS
OFF_NSA_G = OFF_NSA_KV + NSA_KV_COLS
OFF_DQ = OFF_NSA_G + NSA_GATE_COLS
OFF_DK = OFF_DQ + DIFF_Q_COLS
OFF_DV = OFF_DK + DIFF_K_COLS
OFF_MG = OFF_DV + DIFF_V_COLS
IN_COLS = OFF_MG + MERGE_GATE_COLS

kernel_name = "hybrid_nsa_diffattn_convffn_block"


def rms_norm(x, gain):
    xf = x.astype(jnp.float32)
    y = xf * lax.rsqrt(jnp.mean(xf * xf, axis=-1, keepdims=True) + EPS)
    return (y * gain.astype(jnp.float32)).astype(x.dtype)


def t5_bucket(dist):
    n = jnp.maximum(jnp.asarray(dist, jnp.int32), 0)
    max_exact = NUM_BUCKETS // 2
    nf = jnp.maximum(n, max_exact).astype(jnp.float32)
    large = max_exact + (jnp.log(nf / max_exact) / math.log(MAX_DISTANCE / max_exact) * (NUM_BUCKETS - max_exact)).astype(jnp.int32)
    large = jnp.minimum(large, NUM_BUCKETS - 1)
    return jnp.where(n < max_exact, n, large)


def masked_softmax(logits, mask):
    p = jax.nn.softmax(jnp.where(mask, logits, NEG), axis=-1)
    return jnp.where(mask, p, 0.0)


def nsa_mixer(q, kv, gate_logits, cmp_pe, cmp_w1, cmp_w2, q_gain, k_gain, bias_tab):
    B, T = q.shape[0], q.shape[1]
    G, HPG, dk = NSA_KV_GROUPS, NSA_HPG, HEAD_DIM
    scale = dk ** -0.5
    q = rms_norm(q, q_gain)
    qg = q.reshape(B, T, G, HPG, dk).transpose(0, 2, 3, 1, 4)
    bt = bias_tab[:, :NSA_HEADS]
    t_idx = np.arange(T)

    nc = (T - CMP_LEN) // CMP_STRIDE + 1
    starts = np.arange(nc) * CMP_STRIDE
    tok = starts[:, None] + np.arange(CMP_LEN)[None, :]

    def compress(z, i):
        blk = z[:, tok] + cmp_pe[i][:, None, :]
        blk = blk.transpose(0, 1, 3, 2, 4).reshape(B, nc, G, CMP_LEN * dk)
        return jax.nn.gelu(blk @ cmp_w1[i]) @ cmp_w2[i]

    kc = rms_norm(compress(kv[:, :, 0, 0], 0), k_gain[0])
    vc = compress(kv[:, :, 0, 1], 1)
    blk_end = starts + CMP_LEN - 1
    cmask = blk_end[None, :] <= t_idx[:, None]
    cbias = bt[t5_bucket(t_idx[:, None] - blk_end[None, :])].transpose(2, 0, 1).reshape(G, HPG, T, nc)
    s_c = jnp.einsum('bghtd,bcgd->bghtc', qg, kc).astype(jnp.float32) * scale + cbias
    p_cmp = masked_softmax(s_c, cmask)
    o_cmp = jnp.einsum('bghtc,bcgd->bghtd', p_cmp.astype(vc.dtype), vc)

    ns = T // SEL_BLOCK
    n_sel = min(N_SEL, ns)
    sel_start = np.arange(ns) * SEL_BLOCK
    overlap = np.clip(np.minimum(starts[:, None] + CMP_LEN, sel_start[None, :] + SEL_BLOCK)
                      - np.maximum(starts[:, None], sel_start[None, :]), 0, None) / CMP_STRIDE
    imp = jnp.einsum('bghtc,cs->bgts', p_cmp, jnp.asarray(overlap, jnp.float32))
    cur = t_idx // SEL_BLOCK
    j = np.arange(ns)
    causal_blk = j[None, :] <= cur[:, None]
    forced = (j[None, :] == 0) | (j[None, :] == cur[:, None]) | (j[None, :] == cur[:, None] - 1)
    score = jnp.where(forced, 1e4, jnp.where(causal_blk, imp, -1e4))
    _, sel_idx = lax.top_k(score, n_sel)

    k_s = rms_norm(kv[:, :, 1, 0], k_gain[1])
    v_s = kv[:, :, 1, 1]
    kb = k_s.reshape(B, ns, SEL_BLOCK, G, dk).transpose(0, 3, 1, 2, 4)
    vb = v_s.reshape(B, ns, SEL_BLOCK, G, dk).transpose(0, 3, 1, 2, 4)
    nq = T // SEL_Q_CHUNK
    q_ch = qg.reshape(B, G, HPG, nq, SEL_Q_CHUNK, dk).transpose(3, 0, 1, 2, 4, 5)
    idx_ch = sel_idx.reshape(B, G, nq, SEL_Q_CHUNK, n_sel).transpose(2, 0, 1, 3, 4)
    t_ch = jnp.asarray(t_idx.reshape(nq, SEL_Q_CHUNK), jnp.int32)
    bias_grp = bt.reshape(NUM_BUCKETS, G, HPG)
    b_ar = jnp.arange(B)[:, None, None, None]
    g_ar = jnp.arange(G)[None, :, None, None]
    n_keys = n_sel * SEL_BLOCK

    def sel_chunk(args):
        qc, ic, tc = args
        kg = kb[b_ar, g_ar, ic]
        vg = vb[b_ar, g_ar, ic]
        pos = ic[..., None] * SEL_BLOCK + jnp.arange(SEL_BLOCK)
        dist = tc[None, None, :, None, None] - pos
        bias = bias_grp[t5_bucket(dist), g_ar[..., None]].transpose(0, 1, 5, 2, 3, 4)
        s = jnp.einsum('bghqd,bgqnkd->bghqnk', qc, kg).astype(jnp.float32) * scale + bias
        s = s.reshape(B, G, HPG, SEL_Q_CHUNK, n_keys)
        mask = (dist >= 0).reshape(B, G, 1, SEL_Q_CHUNK, n_keys)
        p = masked_softmax(s, mask)
        return jnp.einsum('bghqk,bgqkd->bghqd', p.astype(vg.dtype), vg.reshape(B, G, SEL_Q_CHUNK, n_keys, dk))

    o_slc = lax.map(sel_chunk, (q_ch, idx_ch, t_ch))
    o_slc = o_slc.transpose(1, 2, 3, 0, 4, 5).reshape(B, G, HPG, T, dk)

    k_w = rms_norm(kv[:, :, 2, 0], k_gain[2])
    v_w = kv[:, :, 2, 1]
    nb = T // Q_BLOCK
    nwb = WINDOW // Q_BLOCK
    slab_len = (nwb + 1) * Q_BLOCK

    def to_slab(z):
        zb = z.transpose(0, 2, 1, 3).reshape(B, G, nb, Q_BLOCK, dk)
        zp = jnp.pad(zb, ((0, 0), (0, 0), (nwb, 0), (0, 0), (0, 0)))
        return jnp.concatenate([zp[:, :, s:s + nb] for s in range(nwb + 1)], axis=3)

    k_slab, v_slab = to_slab(k_w), to_slab(v_w)
    rq = np.arange(Q_BLOCK)
    ks = np.arange(slab_len)
    wdist = nwb * Q_BLOCK + rq[:, None] - ks[None, :]
    kpos = (np.arange(nb)[:, None] - nwb) * Q_BLOCK + ks[None, :]
    wmask = ((wdist >= 0) & (wdist < WINDOW))[None] & (kpos >= 0)[:, None, :]
    wbias = bt[t5_bucket(wdist)].transpose(2, 0, 1).reshape(G, HPG, 1, Q_BLOCK, slab_len)
    qw = qg.reshape(B, G, HPG, nb, Q_BLOCK, dk)
    s_w = jnp.einsum('bghnqd,bgnkd->bghnqk', qw, k_slab).astype(jnp.float32) * scale + wbias
    p_w = masked_softmax(s_w, wmask)
    o_win = jnp.einsum('bghnqk,bgnkd->bghnqd', p_w.astype(v_slab.dtype), v_slab).reshape(B, G, HPG, T, dk)

    gt = jax.nn.sigmoid(gate_logits.astype(jnp.float32)).astype(o_win.dtype)
    gt = gt.reshape(B, T, G, HPG, N_NSA_BRANCH).transpose(0, 2, 3, 1, 4)[..., None, :]
    o = gt[..., 0] * o_cmp + gt[..., 1] * o_slc + gt[..., 2] * o_win
    return o.transpose(0, 3, 1, 2, 4).reshape(B, T, NSA_HEADS * dk)


def diff_attention(q, k, v, q_gain, k_gain, lam_q, lam_k, subln_gain, bias_tab, lam_init):
    B, T = q.shape[0], q.shape[1]
    scale = HEAD_DIM ** -0.5
    qh = rms_norm(q, q_gain).transpose(0, 2, 3, 1, 4)
    kh = rms_norm(k, k_gain).transpose(0, 2, 3, 1, 4)
    vh = v.transpose(0, 2, 1, 3)
    lq = lam_q.astype(jnp.float32)
    lk = lam_k.astype(jnp.float32)
    lam = jnp.exp(jnp.sum(lq[0] * lk[0])) - jnp.exp(jnp.sum(lq[1] * lk[1])) + lam_init
    dbt = bias_tab[:, NSA_HEADS:]
    outs = []
    for i in range(T // Q_BLOCK):
        L = (i + 1) * Q_BLOCK
        qi = qh[:, :, :, i * Q_BLOCK:L]
        dist = (i * Q_BLOCK + np.arange(Q_BLOCK))[:, None] - np.arange(L)[None, :]
        bias = dbt[t5_bucket(dist)].transpose(2, 0, 1)
        s = jnp.einsum('bhmqd,bhmkd->bhmqk', qi, kh[:, :, :, :L]).astype(jnp.float32) * scale + bias[None, :, None]
        p = masked_softmax(s, dist >= 0)
        a = p[:, :, 0] - lam * p[:, :, 1]
        outs.append(jnp.einsum('bhqk,bhkd->bhqd', a.astype(vh.dtype), vh[:, :, :L]))
    o = jnp.concatenate(outs, axis=2)
    o = rms_norm(o, subln_gain) * (1.0 - lam_init)
    return o.transpose(0, 2, 1, 3).reshape(B, T, DIFF_HEADS * DIFF_V_DIM)


def setup_inputs(seed: int = 0) -> dict:
    key = jax.random.key(seed)
    ks = jax.random.split(key, 26)
    f32 = jnp.float32

    def nrm(k, shape, s):
        return jax.random.normal(k, shape, f32) * s

    def gain(k, shape):
        return 1.0 + 0.05 * jax.random.normal(k, shape, f32)

    D, F, dk, L = D_MODEL, D_FF, HEAD_DIM, CMP_LEN
    return {
        "x": nrm(ks[0], (BATCH, SEQ, D), 1.0),
        "c": nrm(ks[1], (BATCH, D), 1.0),
        "w_ada": nrm(ks[2], (DEPTH, D, 6 * D), D ** -0.5),
        "b_ada": nrm(ks[3], (DEPTH, 6 * D), 0.02),
        "norm1_gain": gain(ks[4], (DEPTH, D)),
        "norm2_gain": gain(ks[5], (DEPTH, D)),
        "w_in": nrm(ks[6], (DEPTH, D, IN_COLS), D ** -0.5),
        "nsa_q_gain": gain(ks[7], (DEPTH, dk)),
        "nsa_k_gain": gain(ks[8], (DEPTH, N_NSA_BRANCH, dk)),
        "cmp_pe": nrm(ks[9], (DEPTH, 2, L, dk), 0.2),
        "cmp_w1": nrm(ks[10], (DEPTH, 2, L * dk, dk), (L * dk) ** -0.5),
        "cmp_w2": nrm(ks[11], (DEPTH, 2, dk, dk), dk ** -0.5),
        "diff_q_gain": gain(ks[12], (DEPTH, dk)),
        "diff_k_gain": gain(ks[13], (DEPTH, dk)),
        "diff_lambda_q": nrm(ks[14], (DEPTH, 2, dk), 0.1),
        "diff_lambda_k": nrm(ks[15], (DEPTH, 2, dk), 0.1),
        "diff_subln_gain": gain(ks[16], (DEPTH, DIFF_V_DIM)),
        "w_nsa_out": nrm(ks[17], (DEPTH, NSA_Q_COLS, D), NSA_Q_COLS ** -0.5),
        "w_diff_out": nrm(ks[18], (DEPTH, DIFF_V_COLS, D), DIFF_V_COLS ** -0.5),
        "w_o": nrm(ks[19], (DEPTH, D, D), D ** -0.5),
        "w_ffn_up": nrm(ks[20], (DEPTH, D, 2 * F), D ** -0.5),
        "ffn_conv_w": nrm(ks[21], (DEPTH, CONV_WIDTH, 2 * F), CONV_WIDTH ** -0.5),
        "ffn_conv_b": nrm(ks[22], (DEPTH, 2 * F), 0.02),
        "w_ffn_down": nrm(ks[23], (DEPTH, F, D), F ** -0.5),
        "rel_bias": nrm(ks[24], (NUM_BUCKETS, N_BIAS_HEADS), 0.5),
    }


def reference(x, c, w_ada, b_ada, norm1_gain, norm2_gain, w_in, nsa_q_gain, nsa_k_gain, cmp_pe, cmp_w1, cmp_w2,
              diff_q_gain, diff_k_gain, diff_lambda_q, diff_lambda_k, diff_subln_gain, w_nsa_out, w_diff_out, w_o,
              w_ffn_up, ffn_conv_w, ffn_conv_b, w_ffn_down, rel_bias):
    B, T, D = x.shape
    for l in range(DEPTH):
        lam_init = 0.8 - 0.6 * math.exp(-0.3 * l)
        mod = jax.nn.silu(c) @ w_ada[l] + b_ada[l]
        sh1, sc1, g1, sh2, sc2, g2 = [m[:, None, :] for m in jnp.split(mod, 6, axis=-1)]

        h = rms_norm(x, norm1_gain[l]) * (1.0 + sc1) + sh1
        proj = h @ w_in[l]
        nsa_q = proj[..., :OFF_NSA_KV].reshape(B, T, NSA_HEADS, HEAD_DIM)
        nsa_kv = proj[..., OFF_NSA_KV:OFF_NSA_G].reshape(B, T, N_NSA_BRANCH, 2, NSA_KV_GROUPS, HEAD_DIM)
        nsa_g = proj[..., OFF_NSA_G:OFF_DQ].reshape(B, T, NSA_HEADS, N_NSA_BRANCH)
        d_q = proj[..., OFF_DQ:OFF_DK].reshape(B, T, DIFF_HEADS, 2, HEAD_DIM)
        d_k = proj[..., OFF_DK:OFF_DV].reshape(B, T, DIFF_HEADS, 2, HEAD_DIM)
        d_v = proj[..., OFF_DV:OFF_MG].reshape(B, T, DIFF_HEADS, DIFF_V_DIM)
        merge_g = jax.nn.sigmoid(proj[..., OFF_MG:].astype(jnp.float32)).astype(x.dtype).reshape(B, T, N_BRANCHES, D)

        y_nsa = nsa_mixer(nsa_q, nsa_kv, nsa_g, cmp_pe[l], cmp_w1[l], cmp_w2[l], nsa_q_gain[l], nsa_k_gain[l], rel_bias) @ w_nsa_out[l]
        y_diff = diff_attention(d_q, d_k, d_v, diff_q_gain[l], diff_k_gain[l], diff_lambda_q[l], diff_lambda_k[l],
                                diff_subln_gain[l], rel_bias, lam_init) @ w_diff_out[l]
        mixed = (merge_g[:, :, 0] * y_nsa + merge_g[:, :, 1] * y_diff) @ w_o[l]
        x = x + g1 * mixed

        h2 = rms_norm(x, norm2_gain[l]) * (1.0 + sc2) + sh2
        u = h2 @ w_ffn_up[l]
        up = jnp.pad(u, ((0, 0), (CONV_WIDTH - 1, 0), (0, 0)))
        cw = ffn_conv_w[l]
        conv = ffn_conv_b[l] + sum(cw[k] * up[:, k:k + T] for k in range(CONV_WIDTH))
        a, val = jnp.split(conv, 2, axis=-1)
        x = x + g2 * ((jax.nn.silu(a) * val) @ w_ffn_down[l])
    return x
```

```cpp
#include <hip/hip_runtime.h>
#include <hip/hip_cooperative_groups.h>
#include <cstdio>
#include <cstdint>
namespace cg = cooperative_groups;
#define ONE_LAUNCH 1
namespace pg8 {
#define PG8_LAS __attribute__((address_space(3)))
typedef unsigned short bf16_t;
typedef short bf16x8 __attribute__((ext_vector_type(8)));
typedef float f32x4 __attribute__((ext_vector_type(4)));
typedef unsigned u32x4 __attribute__((ext_vector_type(4)));
constexpr int BM = 256, BK = 64, HALF = 128, HTB = HALF * BK * 2  , STAGE_BYTES = 8 * HTB, NXCD = 8, WGM = 8;

__host__ __device__ __forceinline__ int lds_byte(int r, int c) { const int st = (r >> 4) * 2 + (c >> 5), rr = r & 15, cc = c & 31, ob = rr * 64 + cc * 2; return st * 1024 + (ob ^ (((ob >> 9) & 1) << 5)); }
__host__ __device__ __forceinline__ void stage_rc(int b, int& R, int& C) { const int st = b / 1024, sb = b % 1024, swz = sb ^ (((sb >> 9) & 1) << 5); R = (st >> 1) * 16 + swz / 64; C = (st & 1) * 32 + (swz % 64) / 2; }
__host__ __device__ __forceinline__ int perm32(int rho) { const int n = rho >> 4, i = rho & 15; return 8 * (i >> 2) + 4 * n + (i & 3); }

struct Unit { int pm, pn; };
struct Gemm { const bf16_t* A; const bf16_t* Bt; int M, N, K; };

struct StaticOrder {
    int nM, nN, nwg, G, c;
    __host__ __device__ void init(int M, int N, int G_, int c_) { nM = M / BM; nN = N / BM; nwg = nM * nN; G = G_; c = c_; }
    __host__ __device__ bool next(int i, Unit& u) const {
        const long L = (long)i * G + c; if (L >= nwg) return false;
        int wgid = (int)L; { const int q = nwg / NXCD, r = nwg % NXCD, xcd = wgid % NXCD, off = wgid / NXCD; wgid = (xcd < r ? xcd * (q + 1) : r * (q + 1) + (xcd - r) * q) + off; }
        const int nig = WGM * nN, gid = wgid / nig, fm = gid * WGM, gsz = (nM - fm) < WGM ? (nM - fm) : WGM;
        u.pm = fm + ((wgid % nig) % gsz); u.pn = (wgid % nig) / gsz; return true;
    }
    __device__ __forceinline__ void a_ready(const Unit&) const {}
    __device__ __forceinline__ void done(const Unit&) const {}
};
__device__ __forceinline__ unsigned cvt_pk_bf16(float lo, float hi) { unsigned r; asm volatile("v_cvt_pk_bf16_f32 %0, %1, %2" : "=v"(r) : "v"(lo), "v"(hi)); return r; }
typedef unsigned u32x4 __attribute__((ext_vector_type(4)));
__device__ __forceinline__ void st8_bf16(bf16_t* p, f32x4 v0, f32x4 v1) {
    u32x4 w; w.x = cvt_pk_bf16(v0[0], v0[1]); w.y = cvt_pk_bf16(v0[2], v0[3]); w.z = cvt_pk_bf16(v1[0], v1[1]); w.w = cvt_pk_bf16(v1[2], v1[3]);
    *(u32x4*)p = w;
}
__device__ __forceinline__ void ld8_bf16(const bf16_t* p, f32x4& v0, f32x4& v1) {
    const u32x4 w = *(const u32x4*)p;
    v0[0] = __uint_as_float(w.x << 16); v0[1] = __uint_as_float(w.x & 0xffff0000u); v0[2] = __uint_as_float(w.y << 16); v0[3] = __uint_as_float(w.y & 0xffff0000u);
    v1[0] = __uint_as_float(w.z << 16); v1[1] = __uint_as_float(w.z & 0xffff0000u); v1[2] = __uint_as_float(w.w << 16); v1[3] = __uint_as_float(w.w & 0xffff0000u);
}
__device__ __forceinline__ float sigmoidf_(float x) { return 1.0f / (1.0f + __expf(-x)); }

struct EpiInProj {
    static constexpr bool PERM = true, AFTER_DRAIN = false, HAS_MID = false;
    bf16_t *QN, *KV, *DQ, *DK, *DV, *MG; float* G;
    const float *qgain, *kgain, *dqgain, *dkgain;
    PG8_LAS float* xl;
    float qscale, eps;
    __device__ __forceinline__ void operator()(const f32x4 (&acc)[2][2][4][2], const Unit& u, int wr, int wc, int fr, int fq) const {
        const int pn = u.pn, row0 = u.pm * BM + wr * 64 + fr, cw = wc * 32 + 8 * fq;
        int mode; bf16_t* dst; int ldc, cbase, bjs; const float* gain = nullptr; float sc = 1.f;
        constexpr int SL = 8192 * 128;
        if (pn < 4)        { mode = 0; dst = QN + (size_t)(pn * 2) * SL; ldc = 128; cbase = 0; bjs = SL; gain = qgain; sc = qscale; }
        else if (pn < 10)  { const int br = (pn - 4) >> 1, kvsel = (pn - 4) & 1; dst = KV + (size_t)((pn - 4) * 2) * SL; ldc = 128; cbase = 0; bjs = SL;
                             if (kvsel == 0 && br > 0) { mode = 0; gain = kgain + br * 128; } else mode = 1; }
        else if (pn < 14)  { mode = 0; dst = DQ + (size_t)((pn - 10) * 2) * SL; ldc = 128; cbase = 0; bjs = SL; gain = dqgain; sc = qscale; }
        else if (pn < 18)  { mode = 0; dst = DK + (size_t)((pn - 14) * 2) * SL; ldc = 128; cbase = 0; bjs = SL; gain = dkgain; }
        else if (pn < 22)  { mode = 1; dst = DV + (size_t)(pn - 18) * (2 * SL); ldc = 256; cbase = 0; bjs = HALF; }
        else if (pn < 38)  { mode = 2; dst = MG; ldc = 4096; cbase = (pn - 22) * 256; bjs = HALF; }
        else               { mode = 3; dst = nullptr; ldc = 0; cbase = 0; bjs = 0; }
        if (mode == 0) {
#pragma unroll
            for (int ai = 0; ai < 2; ++ai)
#pragma unroll
                for (int m = 0; m < 4; ++m)
#pragma unroll
                    for (int bj = 0; bj < 2; ++bj) {
                        const f32x4 a = acc[ai][bj][m][0], b = acc[ai][bj][m][1];
                        float s = (a[0] * a[0] + a[1] * a[1]) + (a[2] * a[2] + a[3] * a[3]) + (b[0] * b[0] + b[1] * b[1]) + (b[2] * b[2] + b[3] * b[3]);
                        s += __shfl_xor(s, 16); s += __shfl_xor(s, 32);
                        if (fq == 0) xl[(ai * HALF + wr * 64 + m * 16 + fr) * 8 + bj * 4 + wc] = s;
                    }
            asm volatile("s_waitcnt lgkmcnt(0)" ::: "memory"); __builtin_amdgcn_s_barrier(); asm volatile("" ::: "memory");
            f32x4 g0 = *(const f32x4*)(gain + cw), g1 = *(const f32x4*)(gain + cw + 4);
            g0 = g0 * sc; g1 = g1 * sc;
#pragma unroll
            for (int ai = 0; ai < 2; ++ai)
#pragma unroll
                for (int m = 0; m < 4; ++m) { const int rl = ai * HALF + wr * 64 + m * 16 + fr; bf16_t* rowp = dst + (size_t)(u.pm * BM + rl) * ldc + cbase + cw;
#pragma unroll
                    for (int bj = 0; bj < 2; ++bj) {
                        const f32x4 ps = *(const PG8_LAS f32x4*)(xl + rl * 8 + bj * 4);
                        const float rs = rsqrtf(((ps[0] + ps[1]) + (ps[2] + ps[3])) * (1.0f / 128.0f) + eps);
                        st8_bf16(rowp + (size_t)bj * bjs, acc[ai][bj][m][0] * rs * g0, acc[ai][bj][m][1] * rs * g1); } }
        } else if (mode == 1) {
#pragma unroll
            for (int ai = 0; ai < 2; ++ai)
#pragma unroll
                for (int m = 0; m < 4; ++m) { bf16_t* rowp = dst + (size_t)(row0 + ai * HALF + m * 16) * ldc + cbase + cw;
#pragma unroll
                    for (int bj = 0; bj < 2; ++bj) st8_bf16(rowp + (size_t)bj * bjs, acc[ai][bj][m][0], acc[ai][bj][m][1]); }
        } else if (mode == 2) {
#pragma unroll
            for (int ai = 0; ai < 2; ++ai)
#pragma unroll
                for (int m = 0; m < 4; ++m) { bf16_t* rowp = dst + (size_t)(row0 + ai * HALF + m * 16) * ldc + cbase + cw;
#pragma unroll
                    for (int bj = 0; bj < 2; ++bj) { f32x4 a = acc[ai][bj][m][0], b = acc[ai][bj][m][1];
#pragma unroll
                        for (int e = 0; e < 4; ++e) { a[e] = sigmoidf_(a[e]); b[e] = sigmoidf_(b[e]); }
                        st8_bf16(rowp + (size_t)bj * bjs, a, b); } }
        } else {
            if (wc == 0 && fq < 3) {
#pragma unroll
                for (int ai = 0; ai < 2; ++ai)
#pragma unroll
                    for (int m = 0; m < 4; ++m) { float* gp = G + (size_t)(row0 + ai * HALF + m * 16) * 24 + 8 * fq;
                        f32x4 a = acc[ai][0][m][0], b = acc[ai][0][m][1];
#pragma unroll
                        for (int e = 0; e < 4; ++e) { a[e] = sigmoidf_(a[e]); b[e] = sigmoidf_(b[e]); }
                        *(f32x4*)gp = a; *(f32x4*)(gp + 4) = b; }
            }
        }
    }
};

struct EpiMix {
    static constexpr bool PERM = true, AFTER_DRAIN = false, HAS_MID = true;
    const bf16_t* MG; bf16_t* MIX;
    __device__ __forceinline__ void mid(f32x4 (&acc)[2][2][4][2], const Unit& u, int wr, int wc, int fr, int fq) const {
        int c0 = wc * 32 + 8 * fq, row0 = u.pm * BM + wr * 64 + fr; asm volatile("" : "+v"(c0), "+v"(row0));
        const int col0 = u.pn * BM + c0;
#pragma unroll
        for (int ai = 0; ai < 2; ++ai)
#pragma unroll
            for (int m = 0; m < 4; ++m) { const size_t row = (size_t)(row0 + ai * HALF + m * 16);
#pragma unroll
                for (int bj = 0; bj < 2; ++bj) { f32x4 g0, g1, h0, h1; ld8_bf16(MG + row * 4096 + col0 + bj * HALF, g0, g1); ld8_bf16(MG + row * 4096 + 2048 + col0 + bj * HALF, h0, h1);
#pragma unroll
                    for (int e = 0; e < 4; ++e) { acc[ai][bj][m][0][e] *= g0[e] * __builtin_amdgcn_rcpf(fmaxf(h0[e], 1e-30f)); acc[ai][bj][m][1][e] *= g1[e] * __builtin_amdgcn_rcpf(fmaxf(h1[e], 1e-30f)); }
                    __builtin_amdgcn_sched_barrier(0); } }
    }
    __device__ __forceinline__ void operator()(const f32x4 (&acc)[2][2][4][2], const Unit& u, int wr, int wc, int fr, int fq) const {
        int row0 = u.pm * BM + wr * 64 + fr, col0 = u.pn * BM + wc * 32 + 8 * fq; asm volatile("" : "+v"(row0), "+v"(col0));
#pragma unroll
        for (int ai = 0; ai < 2; ++ai)
#pragma unroll
            for (int m = 0; m < 4; ++m) { const size_t row = (size_t)(row0 + ai * HALF + m * 16);
#pragma unroll
                for (int bj = 0; bj < 2; ++bj) { f32x4 h0, h1; ld8_bf16(MG + row * 4096 + 2048 + col0 + bj * HALF, h0, h1);
                    st8_bf16(MIX + row * 2048 + col0 + bj * HALF, h0 * acc[ai][bj][m][0], h1 * acc[ai][bj][m][1]); } }
    }
};
struct EpiResid {
    static constexpr bool PERM = true, AFTER_DRAIN = false, HAS_MID = false;
    const float* base; const float* gate; int gstride; float* out;
    __device__ __forceinline__ void operator()(const f32x4 (&acc)[2][2][4][2], const Unit& u, int wr, int wc, int fr, int fq) const {
        const int row0 = u.pm * BM + wr * 64 + fr, col0 = u.pn * BM + wc * 32 + 8 * fq;
        const float* gp = gate + (size_t)(u.pm >> 3) * gstride + col0;
        f32x4 gv[2][2];
#pragma unroll
        for (int bj = 0; bj < 2; ++bj) { gv[bj][0] = *(const f32x4*)(gp + bj * HALF); gv[bj][1] = *(const f32x4*)(gp + bj * HALF + 4); }
#pragma unroll
        for (int ai = 0; ai < 2; ++ai)
#pragma unroll
            for (int m = 0; m < 4; ++m) { const size_t off = (size_t)(row0 + ai * HALF + m * 16) * 2048 + col0;
#pragma unroll
                for (int bj = 0; bj < 2; ++bj) {
                    const f32x4 x0 = *(const f32x4*)(base + off + bj * HALF), x1 = *(const f32x4*)(base + off + bj * HALF + 4);
                    *(f32x4*)(out + off + bj * HALF) = x0 + gv[bj][0] * acc[ai][bj][m][0];
                    *(f32x4*)(out + off + bj * HALF + 4) = x1 + gv[bj][1] * acc[ai][bj][m][1]; } }
    }
};

__device__ __forceinline__ float dpp_ror(float v, const int n) { return n == 1 ? __int_as_float(__builtin_amdgcn_update_dpp(0, __float_as_int(v), 0x121, 0xf, 0xf, false)) : __int_as_float(__builtin_amdgcn_update_dpp(0, __float_as_int(v), 0x122, 0xf, 0xf, false)); }
__device__ __forceinline__ float silu_fast(float x) { return x * __builtin_amdgcn_rcpf(1.0f + __builtin_amdgcn_exp2f(-1.4426950408889634f * x)); }
struct EpiUpAct {
    static constexpr bool PERM = true, AFTER_DRAIN = false, HAS_MID = false;
    bf16_t* ACT; const float* cw; const float* cb; float* HF; float* HL; PG8_LAS float* xb; int NFc, NUPc;
    __device__ __forceinline__ void operator()(const f32x4 (&acc)[2][2][4][2], const Unit& u, int wr, int wc, int fr, int fq) const {
        int cl = wc * 32 + 8 * fq; asm volatile("" : "+v"(cl));
        const int colt = u.pn * BM;
#pragma unroll
        for (int ai = 0; ai < 2; ++ai)
#pragma unroll
            for (int bj = 0; bj < 2; ++bj)
                if (fr >= 14) { PG8_LAS float* p = xb + ((ai * 2 + wr) * 2 + (fr - 14)) * 256 + bj * HALF + cl; *(PG8_LAS f32x4*)p = acc[ai][bj][3][0]; *(PG8_LAS f32x4*)(p + 4) = acc[ai][bj][3][1]; }
        if (wr == 0 && fr < 2) {
#pragma unroll
            for (int bj = 0; bj < 2; ++bj) { float* p = HF + (size_t)(u.pm * 2 + fr) * NUPc + colt + bj * HALF + cl; *(f32x4*)p = acc[0][bj][0][0]; *(f32x4*)(p + 4) = acc[0][bj][0][1]; } }
        if (wr == 1 && fr >= 14) {
#pragma unroll
            for (int bj = 0; bj < 2; ++bj) { float* p = HL + (size_t)(u.pm * 2 + fr - 14) * NUPc + colt + bj * HALF + cl; *(f32x4*)p = acc[1][bj][3][0]; *(f32x4*)(p + 4) = acc[1][bj][3][1]; } }
        asm volatile("s_waitcnt lgkmcnt(0)" ::: "memory"); __builtin_amdgcn_s_barrier(); asm volatile("" ::: "memory");
        const bool bstart = (u.pm & 7) == 0;
#pragma unroll
        for (int ai = 0; ai < 2; ++ai) {
            const int band = ai * 2 + wr;
            unsigned pk0[4][2];
#pragma unroll
            for (int n = 0; n < 2; ++n) {
                f32x4 cva[4];
#pragma unroll
                for (int bj = 0; bj < 2; ++bj) {
                    const int ch = (bj ? NFc : 0) + u.pn * HALF + cl + 4 * n;
                    const f32x4 w0 = *(const f32x4*)(cw + ch), w1 = *(const f32x4*)(cw + NUPc + ch), w2 = *(const f32x4*)(cw + 2 * NUPc + ch), bb = *(const f32x4*)(cb + ch);
                    f32x4 B0 = {0.f, 0.f, 0.f, 0.f}, B1 = B0;
                    if (band > 0) { const PG8_LAS float* p = xb + ((band - 1) * 2) * 256 + bj * HALF + cl + 4 * n; B0 = *(const PG8_LAS f32x4*)p; B1 = *(const PG8_LAS f32x4*)(p + 256); }
                    f32x4 P1 = B1, P2;
#pragma unroll
                    for (int e = 0; e < 4; ++e) P2[e] = fr == 0 ? B0[e] : B1[e];
#pragma unroll
                    for (int m = 0; m < 4; ++m) {
                        const f32x4 X = acc[ai][bj][m][n]; f32x4 R1, R2, c;
#pragma unroll
                        for (int e = 0; e < 4; ++e) { R1[e] = dpp_ror(X[e], 1); R2[e] = dpp_ror(X[e], 2);
                            const float u1 = fr == 0 ? P1[e] : R1[e], u2 = fr < 2 ? P2[e] : R2[e];
                            c[e] = bb[e] + w0[e] * u2 + w1[e] * u1 + w2[e] * X[e]; }
                        P1 = R1; P2 = R2;
                        if (bj == 0) cva[m] = c;
                        else {
                            f32x4 a;
#pragma unroll
                            for (int e = 0; e < 4; ++e) a[e] = silu_fast(cva[m][e]) * c[e];
                            if (n == 0) { pk0[m][0] = cvt_pk_bf16(a[0], a[1]); pk0[m][1] = cvt_pk_bf16(a[2], a[3]); }
                            else { u32x4 w; w.x = pk0[m][0]; w.y = pk0[m][1]; w.z = cvt_pk_bf16(a[0], a[1]); w.w = cvt_pk_bf16(a[2], a[3]);
                                const bool skip = band == 0 && m == 0 && fr < 2 && !bstart;
                                if (!skip) *(u32x4*)(ACT + (size_t)(u.pm * BM + ai * HALF + wr * 64 + m * 16 + fr) * NFc + u.pn * HALF + cl) = w; }
                        }
                    }
                    __builtin_amdgcn_sched_barrier(0);
                }
            }
        }
    }
};

struct EpiResidNorm {
    static constexpr bool PERM = true, AFTER_DRAIN = true, HAS_MID = false;
    const float* base; const float* gate; int gstride; float* out;
    bf16_t* H; const float* gain; const float* sc; const float* sh;
    unsigned* slots; unsigned* cnt; float eps;
    __device__ __forceinline__ void operator()(const f32x4 (&)[2][2][4][2], const Unit&, int, int, int, int) const {}
    __device__ __forceinline__ void fused(f32x4 (&acc)[2][2][4][2], const Unit& u, int wr, int wc, int fr, int fq, PG8_LAS unsigned char* lds, int wid, int lane) const {
        PG8_LAS float* P = (PG8_LAS float*)lds;
        PG8_LAS float* S = (PG8_LAS float*)(lds + 4096);
        const int row0 = u.pm * BM + wr * 64 + fr, col0 = u.pn * BM + wc * 32 + 8 * fq, bidx = u.pm >> 3;
        { const float* gp = gate + (size_t)bidx * gstride + col0;
          f32x4 gv[2][2];
#pragma unroll
          for (int bj = 0; bj < 2; ++bj) { gv[bj][0] = *(const f32x4*)(gp + bj * HALF); gv[bj][1] = *(const f32x4*)(gp + bj * HALF + 4); }
#pragma unroll
          for (int ai = 0; ai < 2; ++ai)
#pragma unroll
            for (int m = 0; m < 4; ++m) { const size_t off = (size_t)(row0 + ai * HALF + m * 16) * 2048 + col0; float s = 0.f;
#pragma unroll
                for (int bj = 0; bj < 2; ++bj) {
                    const f32x4 x0 = *(const f32x4*)(base + off + bj * HALF), x1 = *(const f32x4*)(base + off + bj * HALF + 4);
                    const f32x4 v0 = x0 + gv[bj][0] * acc[ai][bj][m][0], v1 = x1 + gv[bj][1] * acc[ai][bj][m][1];
                    *(f32x4*)(out + off + bj * HALF) = v0; *(f32x4*)(out + off + bj * HALF + 4) = v1;
                    acc[ai][bj][m][0] = v0; acc[ai][bj][m][1] = v1; asm volatile("" : "+v"(acc[ai][bj][m][0]), "+v"(acc[ai][bj][m][1]));
                    s += (v0[0] * v0[0] + v0[1] * v0[1]) + (v0[2] * v0[2] + v0[3] * v0[3]) + (v1[0] * v1[0] + v1[1] * v1[1]) + (v1[2] * v1[2] + v1[3] * v1[3]); }
                s += __shfl_xor(s, 16); s += __shfl_xor(s, 32);
                if (fq == 0) P[(ai * HALF + wr * 64 + m * 16 + fr) * 4 + wc] = s; } }
        asm volatile("s_waitcnt lgkmcnt(0)" ::: "memory"); __builtin_amdgcn_s_barrier(); asm volatile("" ::: "memory");
        const int prow = wid * 32 + (lane & 31);
        if (lane < 32) { const f32x4 p = *(const PG8_LAS f32x4*)(P + prow * 4);
            __hip_atomic_store(slots + (size_t)(u.pm * BM + prow) * 8 + u.pn, __float_as_uint((p[0] + p[1]) + (p[2] + p[3])), __ATOMIC_RELAXED, __HIP_MEMORY_SCOPE_AGENT); }
        asm volatile("s_waitcnt vmcnt(0)" ::: "memory");
        if (lane == 0) __hip_atomic_fetch_add(cnt + 64 * u.pm, 1u, __ATOMIC_RELAXED, __HIP_MEMORY_SCOPE_AGENT);
        if (wid == 0) { unsigned spins = 0;
            while ((unsigned)__builtin_amdgcn_readfirstlane((int)__hip_atomic_load(cnt + 64 * u.pm, __ATOMIC_RELAXED, __HIP_MEMORY_SCOPE_AGENT)) < 64u && ++spins < (1u << 22)) __builtin_amdgcn_s_sleep(2);
            __builtin_amdgcn_fence(__ATOMIC_ACQUIRE, "agent"); }
        asm volatile("s_waitcnt vmcnt(0) lgkmcnt(0)" ::: "memory"); __builtin_amdgcn_s_barrier(); asm volatile("" ::: "memory");
        if (lane < 32) { const unsigned* sp = slots + (size_t)(u.pm * BM + prow) * 8; float t = 0.f;
#pragma unroll
            for (int k = 0; k < 8; ++k) t += __uint_as_float(__hip_atomic_load(sp + k, __ATOMIC_RELAXED, __HIP_MEMORY_SCOPE_AGENT));
            S[prow] = rsqrtf(t * (1.0f / 2048.0f) + eps); }
        asm volatile("s_waitcnt lgkmcnt(0)" ::: "memory"); __builtin_amdgcn_s_barrier(); asm volatile("" ::: "memory");
#pragma unroll
        for (int bj = 0; bj < 2; ++bj) {
            const int c = col0 + bj * HALF;
            f32x4 g0 = *(const f32x4*)(gain + c), g1 = *(const f32x4*)(gain + c + 4);
            const f32x4 a0 = *(const f32x4*)(sc + (size_t)bidx * gstride + c), a1 = *(const f32x4*)(sc + (size_t)bidx * gstride + c + 4);
            const f32x4 h0 = *(const f32x4*)(sh + (size_t)bidx * gstride + c), h1 = *(const f32x4*)(sh + (size_t)bidx * gstride + c + 4);
            g0 = g0 * (a0 + 1.0f); g1 = g1 * (a1 + 1.0f);
#pragma unroll
            for (int ai = 0; ai < 2; ++ai)
#pragma unroll
                for (int m = 0; m < 4; ++m) { const int rl = ai * HALF + wr * 64 + m * 16 + fr; const float rs = S[rl];
                    st8_bf16(H + (size_t)(u.pm * BM + rl) * 2048 + c, acc[ai][bj][m][0] * rs * g0 + h0, acc[ai][bj][m][1] * rs * g1 + h1); }
        }
    }
};

template <class Epi, class Sched, bool ALIGN_EPI = false, bool SP2 = false>
__device__ __forceinline__ void gemm_phase(PG8_LAS unsigned char* lds, const Gemm g, const Sched& S, const Epi& E, const int tid, const int wid, const int lane) {
    const int wr = wid >> 2, wc = wid & 3, fr = lane & 15, fq = lane >> 4;
    const int K = g.K, nt = K / BK;
    unsigned voffA[2], voffB[2];
#pragma unroll
    for (int i = 0; i < 2; ++i) { int R, C; stage_rc(tid * 16 + i * 8192, R, C); const int Rb = Epi::PERM ? ((R & ~31) + perm32(R & 31)) : R;
        voffA[i] = (unsigned)(R * K + C) * 2u; voffB[i] = (unsigned)(Rb * K + C) * 2u; }
    const size_t kstep = (size_t)(BK * 2);
    const size_t hstep = (size_t)HALF * K * 2;
    const size_t tstep = 2 * hstep;
    const unsigned ldsw = (unsigned)wid * 1024u;
    const int aoff = lds_byte(wr * 64 + fr, fq * 8), boff = lds_byte(wc * 32 + fr, fq * 8);
#define PG8_SA(b, h) (((b) * 2 + (h)) * HTB)
#define PG8_SB(b, h) ((4 + (b) * 2 + (h)) * HTB)
#define PG8_STAGE(bufoff, gbase, voff) do { _Pragma("unroll") for (int _i = 0; _i < 2; ++_i) \
        __builtin_amdgcn_global_load_lds((const unsigned*)((const char*)(gbase) + (voff)[_i]), (PG8_LAS unsigned*)(lds + (bufoff) + ldsw + _i * 8192), 16, 0, 0); } while (0)
#define PG8_LDA(dst, b, h) do { _Pragma("unroll") for (int m = 0; m < 4; ++m) _Pragma("unroll") for (int k = 0; k < 2; ++k) dst[m][k] = *(const PG8_LAS bf16x8*)(lds + PG8_SA(b, h) + aoff + m * 2048 + k * 1024); } while (0)
#define PG8_LDB(dst, b, h) do { _Pragma("unroll") for (int n = 0; n < 2; ++n) _Pragma("unroll") for (int k = 0; k < 2; ++k) dst[n][k] = *(const PG8_LAS bf16x8*)(lds + PG8_SB(b, h) + boff + n * 2048 + k * 1024); } while (0)
#define PG8_MMA(ai, bj, At, Bt) do { __builtin_amdgcn_s_setprio(1); _Pragma("unroll") for (int m = 0; m < 4; ++m) _Pragma("unroll") for (int n = 0; n < 2; ++n) _Pragma("unroll") for (int k = 0; k < 2; ++k) \
        acc[ai][bj][m][n] = __builtin_amdgcn_mfma_f32_16x16x32_bf16(Bt[n][k], At[m][k], acc[ai][bj][m][n], 0, 0, 0); __builtin_amdgcn_s_setprio(0); } while (0)
#define PG8_WAIT_V(n) asm volatile("s_waitcnt vmcnt(" #n ")" ::: "memory")
#define PG8_WAIT_L(n) asm volatile("s_waitcnt lgkmcnt(" #n ")" ::: "memory")
#define PG8_BAR __builtin_amdgcn_s_barrier()
#define PG8_SCHED __builtin_amdgcn_sched_barrier(0)
    Unit cur, nxt; int ui = 0;
    if (!S.next(0, cur)) return;
    f32x4 acc[2][2][4][2];
#pragma unroll
    for (int a = 0; a < 2; ++a)
#pragma unroll
        for (int b = 0; b < 2; ++b)
#pragma unroll
            for (int m = 0; m < 4; ++m)
#pragma unroll
                for (int n = 0; n < 2; ++n) acc[a][b][m][n] = (f32x4){0.f, 0.f, 0.f, 0.f};
    bf16x8 At[4][2], B0[2][2], B1[2][2];
    const char* cA = (const char*)g.A + (size_t)cur.pm * tstep; const char* cB = (const char*)g.Bt + (size_t)cur.pn * tstep;
    S.a_ready(cur);
    if constexpr (SP2) {
        PG8_STAGE(PG8_SB(0, 0), cB, voffB); PG8_STAGE(PG8_SB(0, 1), cB + hstep, voffB); PG8_STAGE(PG8_SA(0, 0), cA, voffA); PG8_STAGE(PG8_SA(0, 1), cA + hstep, voffA);
        if (wr == 1) PG8_BAR;
        PG8_WAIT_V(2); PG8_BAR;
        PG8_STAGE(PG8_SB(1, 0), cB + kstep, voffB); PG8_STAGE(PG8_SA(1, 0), cA + kstep, voffA); PG8_STAGE(PG8_SB(1, 1), cB + hstep + kstep, voffB);
        PG8_WAIT_V(6); PG8_BAR;
    } else {
        PG8_STAGE(PG8_SB(0, 0), cB, voffB); PG8_STAGE(PG8_SA(0, 0), cA, voffA); PG8_STAGE(PG8_SB(0, 1), cB + hstep, voffB); PG8_STAGE(PG8_SA(0, 1), cA + hstep, voffA);
        if (wr == 1) PG8_BAR;
        PG8_WAIT_V(4); PG8_BAR;
        PG8_STAGE(PG8_SB(1, 0), cB + kstep, voffB); PG8_STAGE(PG8_SA(1, 0), cA + kstep, voffA); PG8_STAGE(PG8_SB(1, 1), cB + hstep + kstep, voffB);
        PG8_WAIT_V(6); PG8_BAR;
    }
    for (;;) {
        const bool has_next = S.next(ui + 1, nxt);
        const char* nA = has_next ? (const char*)g.A + (size_t)nxt.pm * tstep : cA; const char* nB = has_next ? (const char*)g.Bt + (size_t)nxt.pn * tstep : cB;
        for (int t = 0; t < nt; t += 2) {
            if constexpr (Epi::HAS_MID) { if (t == nt / 2) E.mid(acc, cur, wr, wc, fr, fq); }
            const bool last = (t == nt - 2);
            const char* a1 = cA + (size_t)(t + 1) * kstep;
            const char* a2 = last ? nA : cA + (size_t)(t + 2) * kstep; const char* b2 = last ? nB : cB + (size_t)(t + 2) * kstep;
            const char* a3 = a2 + kstep; const char* b3 = b2 + kstep;
            if (last && has_next) S.a_ready(nxt);
            if constexpr (SP2) {
            PG8_LDB(B0, 0, 0); PG8_LDB(B1, 0, 1); PG8_SCHED; PG8_LDA(At, 0, 0); PG8_STAGE(PG8_SA(1, 1), a1 + hstep, voffA);
            PG8_WAIT_V(8); PG8_WAIT_L(0); PG8_BAR; PG8_MMA(0, 0, At, B0); PG8_MMA(0, 1, At, B1); PG8_BAR; PG8_SCHED;
            PG8_LDA(At, 0, 1); PG8_STAGE(PG8_SB(0, 0), b2, voffB); PG8_STAGE(PG8_SB(0, 1), b2 + hstep, voffB); PG8_STAGE(PG8_SA(0, 0), a2, voffA);
            PG8_WAIT_V(8); PG8_WAIT_L(0); PG8_BAR; PG8_MMA(1, 0, At, B0); PG8_MMA(1, 1, At, B1); PG8_BAR; PG8_SCHED;
            PG8_LDB(B0, 1, 0); PG8_LDB(B1, 1, 1); PG8_SCHED; PG8_LDA(At, 1, 0); PG8_STAGE(PG8_SA(0, 1), a2 + hstep, voffA);
            PG8_WAIT_V(8); PG8_WAIT_L(0); PG8_BAR; PG8_MMA(0, 0, At, B0); PG8_MMA(0, 1, At, B1); PG8_BAR; PG8_SCHED;
            PG8_LDA(At, 1, 1); PG8_STAGE(PG8_SB(1, 0), b3, voffB); PG8_STAGE(PG8_SB(1, 1), b3 + hstep, voffB); PG8_STAGE(PG8_SA(1, 0), a3, voffA);
            PG8_WAIT_V(8); PG8_WAIT_L(0); PG8_BAR; PG8_MMA(1, 0, At, B0); PG8_MMA(1, 1, At, B1); PG8_BAR; PG8_SCHED;
            } else {
            PG8_LDB(B0, 0, 0); PG8_SCHED; PG8_LDA(At, 0, 0); PG8_STAGE(PG8_SA(1, 1), a1 + hstep, voffA);
            PG8_WAIT_L(8); PG8_BAR; PG8_WAIT_L(0); PG8_MMA(0, 0, At, B0); PG8_BAR; PG8_SCHED;
            PG8_LDB(B1, 0, 1); PG8_STAGE(PG8_SB(0, 0), b2, voffB);
            PG8_BAR; PG8_WAIT_L(0); PG8_MMA(0, 1, At, B1); PG8_BAR;
            PG8_LDA(At, 0, 1); PG8_STAGE(PG8_SA(0, 0), a2, voffA);
            PG8_BAR; PG8_WAIT_L(0); PG8_MMA(1, 0, At, B0); PG8_BAR; PG8_SCHED;
            PG8_STAGE(PG8_SB(0, 1), b2 + hstep, voffB);
            PG8_WAIT_V(6); PG8_BAR; PG8_MMA(1, 1, At, B1); PG8_BAR;
            PG8_LDB(B0, 1, 0); PG8_SCHED; PG8_LDA(At, 1, 0); PG8_STAGE(PG8_SA(0, 1), a2 + hstep, voffA);
            PG8_WAIT_L(8); PG8_BAR; PG8_WAIT_L(0); PG8_MMA(0, 0, At, B0); PG8_BAR; PG8_SCHED;
            PG8_LDB(B1, 1, 1); PG8_STAGE(PG8_SB(1, 0), b3, voffB);
            PG8_BAR; PG8_WAIT_L(0); PG8_MMA(0, 1, At, B1); PG8_BAR;
            PG8_LDA(At, 1, 1); PG8_STAGE(PG8_SA(1, 0), a3, voffA);
            PG8_BAR; PG8_WAIT_L(0); PG8_MMA(1, 0, At, B0); PG8_BAR; PG8_SCHED;
            PG8_STAGE(PG8_SB(1, 1), b3 + hstep, voffB);
            PG8_WAIT_V(6); PG8_BAR; PG8_MMA(1, 1, At, B1); PG8_BAR;
            }
        }
        if constexpr (ALIGN_EPI) { if (wr == 0) PG8_BAR; }
        if constexpr (!Epi::AFTER_DRAIN) { E(acc, cur, wr, wc, fr, fq); S.done(cur); }
        if (!has_next) break;
#pragma unroll
        for (int a = 0; a < 2; ++a)
#pragma unroll
            for (int b = 0; b < 2; ++b)
#pragma unroll
                for (int m = 0; m < 4; ++m)
#pragma unroll
                    for (int n = 0; n < 2; ++n) acc[a][b][m][n] = (f32x4){0.f, 0.f, 0.f, 0.f};
        cur = nxt; cA = nA; cB = nB; ++ui;
        if constexpr (ALIGN_EPI) { if (wr == 1) PG8_BAR; }
    }
    PG8_WAIT_V(0);
    if constexpr (!ALIGN_EPI) { if (wr == 0) PG8_BAR; }
    PG8_BAR;
    if constexpr (Epi::AFTER_DRAIN) { E.fused(acc, cur, wr, wc, fr, fq, lds, wid, lane); S.done(cur); }
#undef PG8_SA
#undef PG8_SB
#undef PG8_STAGE
#undef PG8_LDA
#undef PG8_LDB
#undef PG8_MMA
#undef PG8_WAIT_V
#undef PG8_WAIT_L
#undef PG8_BAR
#undef PG8_SCHED
}
}
#define LAS __attribute__((address_space(3)))
typedef unsigned short bf16;
typedef short bf16x8 __attribute__((ext_vector_type(8)));
typedef short s16x4 __attribute__((ext_vector_type(4)));
typedef float f32x4 __attribute__((ext_vector_type(4)));
typedef float f32x16 __attribute__((ext_vector_type(16)));
typedef unsigned u32x4 __attribute__((ext_vector_type(4)));
typedef unsigned u32x2 __attribute__((ext_vector_type(2)));

constexpr int NB = 4, NT = 2048, ND = 2048, NM = NB * NT;
constexpr int NF = 5632, NUP = 2 * NF;
constexpr int NIN_SRC = 9752, NIN = 9984;
constexpr float EPSF = 1e-6f, LOG2E = 1.4426950408889634f, QSCALE = 0.08838834764831845f * 1.4426950408889634f;
constexpr float LAM_INIT = 0.2f;
constexpr int NWAVES = 8, NTHR = 512;

constexpr size_t MiB = 1u << 20;
constexpr size_t WS_SMALL = 0;
constexpr size_t WS_WUP = 4 * MiB;
constexpr size_t WS_WDOWN = 48 * MiB;
constexpr size_t WS_WO = 70 * MiB;
constexpr size_t WS_WNSA = 78 * MiB;
constexpr size_t WS_WIN = 86 * MiB;
constexpr size_t WS_WC1 = 125 * MiB;
constexpr size_t WS_H = 127 * MiB;
constexpr size_t WS_MIX = 159 * MiB;
constexpr size_t WS_QN = 191 * MiB;
constexpr size_t WS_KV = 207 * MiB;
constexpr size_t WS_DQ = 231 * MiB;
constexpr size_t WS_DK = 247 * MiB;
constexpr size_t WS_DV = 263 * MiB;
constexpr size_t WS_MG = 279 * MiB;
constexpr size_t WS_ONSA = 343 * MiB;
constexpr size_t WS_HF = 375 * MiB;
constexpr size_t WS_HL = 378 * MiB;
constexpr size_t WS_END = 381 * MiB;
constexpr size_t WS_DTMP = 127 * MiB;
constexpr size_t WS_NSATMP = 86 * MiB;
constexpr size_t WS_ACT2 = 191 * MiB;
constexpr size_t SM_MOD = 0;
constexpr size_t SM_LAM = 262144;
constexpr size_t SM_CPART = 266240;
constexpr size_t SM_KC = 524288;
constexpr size_t SM_VC = 786432;
constexpr size_t SM_G = 1048576;
constexpr size_t SM_SLOTS = 2 * MiB;
constexpr size_t SM_BAR = 3 * MiB, SM_QCTR = SM_BAR + 16384, SM_PCNT = SM_QCTR + 1024, SM_BAR_BYTES = 16384 + 1024 + 32 * 256;
static_assert(SM_G + 786432 <= 4 * MiB, "small map");

constexpr int RING_BYTES = 131072;
constexpr int XL_OFF = 131072;
constexpr int LDS_BYTES = 157696;
constexpr int MISC_OFF = LDS_BYTES - 64;
constexpr int A_KBUF = 0, A_VBUF = 49152, A_WSCR = 147456, A_BIAS = 149504;
constexpr int A_IMPP = A_VBUF + 16384, A_IMPP2 = A_VBUF + 32768 + 16384, A_SC = A_VBUF + 65536 + 16384, A_SMASK = A_SC + 8448, A_UN = A_SMASK + 256;
static_assert(A_BIAS + 6528 + 32 <= LDS_BYTES - 64, "lds map");

__device__ const unsigned char T5_BUCKET[128] = {0, 1, 2, 3, 4, 5, 6, 7, 8, 9, 10, 11, 12, 13, 14, 15, 16, 16, 16, 17, 17, 18, 18, 18, 19, 19, 19, 20, 20, 20, 20, 21, 21, 21, 21, 22, 22, 22, 22, 22, 23, 23, 23, 23, 23, 23, 24, 24, 24, 24, 24, 24, 25, 25, 25, 25, 25, 25, 25, 26, 26, 26, 26, 26, 26, 26, 26, 27, 27, 27, 27, 27, 27, 27, 27, 27, 27, 28, 28, 28, 28, 28, 28, 28, 28, 28, 28, 29, 29, 29, 29, 29, 29, 29, 29, 29, 29, 29, 29, 30, 30, 30, 30, 30, 30, 30, 30, 30, 30, 30, 30, 30, 30, 31, 31, 31, 31, 31, 31, 31, 31, 31, 31, 31, 31, 31, 31, 31};

#define LDS_WAIT() asm volatile("s_waitcnt lgkmcnt(0)" ::: "memory")
#define VM_WAIT() asm volatile("s_waitcnt vmcnt(0)" ::: "memory")
__device__ __forceinline__ unsigned f2bf(float f) { unsigned u = __builtin_bit_cast(unsigned, f); return (u + 0x7fffu + ((u >> 16) & 1u)) >> 16; }
__device__ __forceinline__ unsigned pk2(float lo, float hi) { return f2bf(lo) | (f2bf(hi) << 16); }
__device__ __forceinline__ float bf2f(unsigned short h) { return __uint_as_float((unsigned)h << 16); }
__device__ __forceinline__ float wave_sum(float v) {
#pragma unroll
    for (int o = 1; o < 64; o <<= 1) v += __shfl_xor(v, o);
    return v;
}
__device__ __forceinline__ float silu_(float x) { return x / (1.0f + __expf(-x)); }
__device__ __forceinline__ float gelu_tanh_(float x) { const float y = 0.7978845608028654f * (x + 0.044715f * x * x * x); const float t = 1.0f - 2.0f / (__expf(2.0f * y) + 1.0f); return 0.5f * x * (1.0f + t); }

struct Args { const float* in[25]; float* out; unsigned char* ws; int ph_lo, ph_hi; };
typedef const __attribute__((address_space(4))) Args* ArgP;
__device__ __forceinline__ ArgP argp() { ArgP p = (ArgP)__builtin_amdgcn_kernarg_segment_ptr(); asm volatile("" : "+s"(p)); return p; }

__device__ __forceinline__ void p0_transpose_item(const float* W, int K  , int Nsrc, bf16* WT, int k0, int n0, int s0, int nvalid, LAS unsigned* scr, int lane, int kdst = 0  ) {
    const int kq = lane >> 4, nq = lane & 15;
    const bool ok = 4 * nq < nvalid;
    const float* src = W + (size_t)(k0 + 2 * kq) * Nsrc + s0 + 4 * nq;
    f32x4 v[8][2];
#pragma unroll
    for (int i = 0; i < 8; ++i)
#pragma unroll
        for (int h = 0; h < 2; ++h) v[i][h] = ok ? __builtin_nontemporal_load((const f32x4*)(src + (size_t)(8 * i + h) * Nsrc)) : (f32x4){0.f, 0.f, 0.f, 0.f};
#pragma unroll
    for (int i = 0; i < 8; ++i) { const int kp = 4 * i + kq;
#pragma unroll
        for (int e = 0; e < 4; ++e) scr[(4 * nq + e) * 33 + kp] = pk2(v[i][0][e], v[i][1][e]); }
    LDS_WAIT(); asm volatile("" ::: "memory");
    const int c = lane & 7;
#pragma unroll
    for (int j = 0; j < 8; ++j) { const int n = 8 * j + (lane >> 3); const LAS unsigned* s = scr + n * 33 + 4 * c;
        u32x4 o; o.x = s[0]; o.y = s[1]; o.z = s[2]; o.w = s[3];
        __builtin_nontemporal_store(o, (u32x4*)(WT + (size_t)(n0 + n) * K + kdst + k0 + 8 * c)); }
    LDS_WAIT(); asm volatile("" ::: "memory");
}
constexpr int WI_IN = 32 * (NIN / 64), WI_C1 = 64 * 2, WI_UP = 32 * (NUP / 64), WI_DN = (NF / 64) * (ND / 64), WI_O = 32 * 32, WI_NS = 16 * 32;
constexpr int WI_A = WI_IN + 2 * WI_C1, WI_B = WI_UP + WI_DN + WI_O + 2 * WI_NS;
__device__ __forceinline__ void weight_item_a(ArgP a, LAS unsigned* scr, int r, int lane) {
    unsigned char* ws = a->ws;
    if (r < WI_IN) { const int nb = r % (NIN / 64), kb = r / (NIN / 64), n0 = nb * 64; int s0, nv;
        if (n0 < 2560) { s0 = n0; nv = 64; } else if (n0 < 9728) { s0 = n0 + 24; nv = 64; } else if (n0 == 9728) { s0 = 2560; nv = 24; } else { s0 = 0; nv = 0; }
        p0_transpose_item(a->in[6], ND, NIN_SRC, (bf16*)(ws + WS_WIN), kb * 64, n0, s0, nv, scr, lane); return; } r -= WI_IN;
    { const int i = r / WI_C1, rr = r % WI_C1, nb = rr % 2, kb = rr / 2;
      p0_transpose_item(a->in[10] + (size_t)i * 4096 * 128, 4096, 128, (bf16*)(ws + WS_WC1) + (size_t)i * 128 * 4096, kb * 64, nb * 64, nb * 64, 64, scr, lane); }
}
__device__ __forceinline__ void weight_item_b(ArgP a, LAS unsigned* scr, int r, int lane) {
    unsigned char* ws = a->ws;
    if (r < WI_NS) { const int nb = r % 32, kb = r / 32; p0_transpose_item(a->in[17], 2048, ND, (bf16*)(ws + WS_WNSA), kb * 64, nb * 64, nb * 64, 64, scr, lane, 0); return; } r -= WI_NS;
    if (r < WI_NS) { const int nb = r % 32, kb = r / 32; p0_transpose_item(a->in[18], 2048, ND, (bf16*)(ws + WS_WNSA), kb * 64, nb * 64, nb * 64, 64, scr, lane, 1024); return; } r -= WI_NS;
    if (r < WI_O) { const int nb = r % 32, kb = r / 32; p0_transpose_item(a->in[19], ND, ND, (bf16*)(ws + WS_WO), kb * 64, nb * 64, nb * 64, 64, scr, lane); return; } r -= WI_O;
    if (r < WI_UP) { const int nb = r % (NUP / 64), kb = r / (NUP / 64), n0 = nb * 64; const int pn = n0 >> 8, rr = n0 & 255;
        const int s0 = (rr < 128) ? (pn * 128 + rr) : (NF + pn * 128 + rr - 128);
        p0_transpose_item(a->in[20], ND, NUP, (bf16*)(ws + WS_WUP), kb * 64, n0, s0, 64, scr, lane); return; } r -= WI_UP;
    { const int nb = r % (ND / 64), kb = r / (ND / 64); p0_transpose_item(a->in[23], NF, ND, (bf16*)(ws + WS_WDOWN), kb * 64, nb * 64, nb * 64, 64, scr, lane); }
}
__device__ __forceinline__ void p0_weights(ArgP a, LAS unsigned char* lds, int gw, int NGW, int wave, int lane) {
    LAS unsigned* scr = (LAS unsigned*)(lds + wave * 16384);
    for (int it = gw; it < WI_A; it += NGW) weight_item_a(a, scr, it, lane);
}
__device__ __forceinline__ void weights_b_queue(ArgP a, LAS unsigned char* lds, int wave, int lane) {
    LAS unsigned* scr = (LAS unsigned*)(lds + wave * 16384);
    unsigned* ctr = (unsigned*)(a->ws + WS_SMALL + SM_QCTR) + 2;
    for (;;) {
        unsigned c = 0; if (lane == 0) c = __hip_atomic_fetch_add(ctr, 1u, __ATOMIC_RELAXED, __HIP_MEMORY_SCOPE_AGENT);
        const int chunk = __builtin_amdgcn_readfirstlane((int)c);
        if (chunk * 8 >= WI_B) break;
        for (int k = 0; k < 8; ++k) { const int it = chunk * 8 + k; if (it < WI_B) weight_item_b(a, scr, it, lane); }
    }
}
__device__ __forceinline__ void p0_adaln(ArgP a, LAS unsigned char* lds, int tid) {
    LAS float* sc = (LAS float*)lds;
    LAS float* red = (LAS float*)(lds + 32768);
    const float* c = a->in[1]; const float* W = a->in[2]; const float* bias = a->in[3]; float* mod = (float*)(a->ws + WS_SMALL + SM_MOD);
    for (int i = tid; i < 4 * 2048; i += NTHR) sc[i] = silu_(c[i]);
    __syncthreads();
    for (int jb = blockIdx.x; jb < 256; jb += gridDim.x) {
        const int j0 = jb * 48, jq = tid % 12, kg = tid / 12;
        if (kg < 42) {
            f32x4 acc0 = {0, 0, 0, 0}, acc1 = acc0, acc2 = acc0, acc3 = acc0;
#pragma unroll 7
            for (int k = kg; k < 2048; k += 42) {
                const f32x4 w = *(const f32x4*)(W + (size_t)k * 12288 + j0 + jq * 4);
                acc0 += w * sc[k]; acc1 += w * sc[2048 + k]; acc2 += w * sc[4096 + k]; acc3 += w * sc[6144 + k];
            }
            LAS float* rp = red + kg * 192 + jq * 4;
            *(LAS f32x4*)(rp) = acc0; *(LAS f32x4*)(rp + 48) = acc1; *(LAS f32x4*)(rp + 96) = acc2; *(LAS f32x4*)(rp + 144) = acc3;
        }
        __syncthreads();
        if (tid < 192) { float s = 0.f; for (int g = 0; g < 42; ++g) s += red[g * 192 + tid]; const int b = tid / 48, j = j0 + tid % 48; mod[b * 12288 + j] = s + bias[j]; }
        __syncthreads();
    }
}
__device__ __forceinline__ void p0_small(ArgP a, int tid) {
    unsigned char* ws = a->ws;
    if (blockIdx.x == 0 && tid < 64) {
        const float* lq = a->in[14]; const float* lk = a->in[15];
        const float s0 = wave_sum(lq[tid] * lk[tid] + lq[64 + tid] * lk[64 + tid]);
        const float s1 = wave_sum(lq[128 + tid] * lk[128 + tid] + lq[192 + tid] * lk[192 + tid]);
        if (tid == 0) *(float*)(ws + WS_SMALL + SM_LAM) = __expf(s0) - __expf(s1) + LAM_INIT;
    }
    for (int kc = blockIdx.x; kc < 32; kc += gridDim.x) {
        if (tid < 256) { const int i = tid >> 7, n = tid & 127; const float* pe = a->in[9] + i * 4096 + kc * 128; const float* w1 = a->in[10] + ((size_t)i * 4096 + kc * 128) * 128 + n;
            float s = 0.f;
#pragma unroll 8
            for (int k = 0; k < 128; ++k) s += pe[k] * w1[(size_t)k * 128];
            ((float*)(ws + WS_SMALL + SM_CPART))[kc * 256 + tid] = s; }
    }
    { const int g = blockIdx.x * NTHR + tid; if (g < 8 * 128) { const int bg = g >> 7, d = g & 127;
        ((bf16*)(ws + WS_SMALL + SM_KC))[(bg * 128 + 127) * 128 + d] = 0; ((bf16*)(ws + WS_SMALL + SM_VC))[(bg * 128 + 127) * 128 + d] = 0; } }
}

__device__ __forceinline__ void norm_rows(const float* X, const float* gain, const float* sh, const float* scl, bf16* H, int gw, int NGW, int lane) {
    for (int row = gw; row < NM; row += NGW) {
        const int b = row >> 11;
        const f32x4* xr = (const f32x4*)(X + (size_t)row * ND) + lane;
        f32x4 v[8]; float s = 0.f;
#pragma unroll
        for (int j = 0; j < 8; ++j) { v[j] = xr[64 * j]; s += (v[j][0] * v[j][0] + v[j][1] * v[j][1]) + (v[j][2] * v[j][2] + v[j][3] * v[j][3]); }
        const float rs = rsqrtf(wave_sum(s) * (1.0f / ND) + EPSF);
        u32x2* o = (u32x2*)(H + (size_t)row * ND) + lane;
#pragma unroll
        for (int j = 0; j < 8; ++j) { const int c = 256 * j + 4 * lane;
            const f32x4 g = *(const f32x4*)(gain + c), a1 = *(const f32x4*)(scl + b * 12288 + c), a0 = *(const f32x4*)(sh + b * 12288 + c);
            const f32x4 y = v[j] * rs * g * (a1 + 1.0f) + a0;
            u32x2 w; w.x = pk2(y[0], y[1]); w.y = pk2(y[2], y[3]); o[64 * j] = w; }
    }
}

__device__ __forceinline__ void act_fixup(const float* HF, const float* HL, const float* cw, const float* cb, bf16* ACT, int pm, int tid) {
    if ((pm & 7) == 0) return;
    const float* f0 = HF + (size_t)(pm * 2) * NUP; const float* f1 = f0 + NUP;
    const float* l0 = HL + (size_t)((pm - 1) * 2) * NUP; const float* l1 = l0 + NUP;
    for (int j = tid; j < NF; j += NTHR) {
        const int ca = (j >> 7) * 256 + (j & 127), cv = ca + 128;
        const float wa0 = cw[j], wa1 = cw[NUP + j], wa2 = cw[2 * NUP + j], wv0 = cw[NF + j], wv1 = cw[NUP + NF + j], wv2 = cw[2 * NUP + NF + j], ba = cb[j], bv = cb[NF + j];
        const float a_m2 = l0[ca], a_m1 = l1[ca], a_0 = f0[ca], a_1 = f1[ca], v_m2 = l0[cv], v_m1 = l1[cv], v_0 = f0[cv], v_1 = f1[cv];
        const float c0a = ba + wa0 * a_m2 + wa1 * a_m1 + wa2 * a_0, c0v = bv + wv0 * v_m2 + wv1 * v_m1 + wv2 * v_0;
        const float c1a = ba + wa0 * a_m1 + wa1 * a_0 + wa2 * a_1, c1v = bv + wv0 * v_m1 + wv1 * v_0 + wv2 * v_1;
        ACT[(size_t)(pm * 256) * NF + j] = (bf16)f2bf(silu_(c0a) * c0v);
        ACT[(size_t)(pm * 256 + 1) * NF + j] = (bf16)f2bf(silu_(c1a) * c1v);
    }
}
#define XB_TMO      128
#define XB_XCNT(j)  (256  + 64 * (j))
#define XB_XSUB(j)  (1280 + 64 * (j))
#define XB_XGEN(j)  (2304 + 64 * (j))
#define XB_TOP      3328
#define XB_TOPGEN   3392
#define XCD_BAR_WORDS 3456
#define XB_SPIN_CAP (1u << 18)

__device__ __forceinline__ unsigned xb_ld(unsigned* p)              { return __hip_atomic_load(p, __ATOMIC_RELAXED, __HIP_MEMORY_SCOPE_AGENT); }
__device__ __forceinline__ unsigned xb_add(unsigned* p, unsigned v) { return __hip_atomic_fetch_add(p, v, __ATOMIC_RELAXED, __HIP_MEMORY_SCOPE_AGENT); }
__device__ __forceinline__ unsigned xb_xcc_id() { return (unsigned)__builtin_amdgcn_s_getreg((3 << 11) | 20) & 0xFu; }
#define XB_SPIN(cond, bar) do { unsigned _sp = 0; while (cond) { __builtin_amdgcn_s_sleep(1); \
    if ((++_sp & 255u) == 0u) { if (xb_ld(&(bar)[XB_TMO])) break; if (_sp > XB_SPIN_CAP) { atomicAdd(&(bar)[XB_TMO], 1u); break; } } } } while (0)

struct XcdBarrier {
    unsigned* bar; unsigned x;
    volatile LAS unsigned* st;
};

__device__ __forceinline__ XcdBarrier xcd_barrier_post(unsigned* bar, volatile LAS unsigned* st, int tid) {
    XcdBarrier b; b.bar = bar; b.x = xb_xcc_id(); b.st = st;
    if (tid == 0) (void)xb_add(&bar[XB_XCNT(b.x)], 1u);
    return b;
}
__device__ __forceinline__ void xcd_barrier_complete(unsigned* bar, unsigned x, unsigned& nloc, unsigned& nx) {
    const unsigned G = gridDim.x * gridDim.y * gridDim.z;
    unsigned sum, cnt, mine, sp = 0u;
    for (;;) {
        sum = 0u; cnt = 0u; mine = 0u;
#pragma unroll
        for (unsigned j = 0; j < 16; ++j) { const unsigned c = xb_ld(&bar[XB_XCNT(j)]); sum += c; cnt += (c > 0u) ? 1u : 0u; mine = (j == x) ? c : mine; }
        if (sum == G) break;
        __builtin_amdgcn_s_sleep(1);
        if ((++sp & 255u) == 0u) { if (xb_ld(&bar[XB_TMO])) break; if (sp > XB_SPIN_CAP) { atomicAdd(&bar[XB_TMO], 1u); break; } }
    }
    nloc = mine > 0u ? mine : 1u; nx = cnt > 0u ? cnt : 1u;
}

__device__ __forceinline__ void xcd_barrier(const XcdBarrier& b, int tid) {
    asm volatile("s_waitcnt vmcnt(0)" ::: "memory");
    __syncthreads();
    if (tid == 0) {
        unsigned* bar = b.bar;
        __builtin_amdgcn_s_waitcnt(0);
        unsigned nloc = b.st[0], nx = b.st[1];
        if (nloc == 0u) { xcd_barrier_complete(bar, b.x, nloc, nx); b.st[0] = nloc; b.st[1] = nx; }
        const unsigned old = xb_add(&bar[XB_XSUB(b.x)], 1u);
        const unsigned gen = old / nloc;
        if (old + 1u == (gen + 1u) * nloc) {
            __builtin_amdgcn_fence(__ATOMIC_RELEASE, "agent");
            asm volatile("s_waitcnt vmcnt(0)" ::: "memory");
            const unsigned og = xb_add(&bar[XB_TOP], 1u);
            const unsigned tg = og / nx;
            if (og + 1u == (tg + 1u) * nx) xb_add(&bar[XB_TOPGEN], 1u);
            else XB_SPIN(xb_ld(&bar[XB_TOPGEN]) == tg, bar);
            __builtin_amdgcn_fence(__ATOMIC_ACQUIRE, "agent");
            xb_add(&bar[XB_XGEN(b.x)], 1u);
            asm volatile("s_waitcnt vmcnt(0)" ::: "memory");
        } else {
            XB_SPIN(xb_ld(&bar[XB_XGEN(b.x)]) == gen, bar);
            __builtin_amdgcn_fence(__ATOMIC_ACQUIRE, "agent");
            asm volatile("s_waitcnt vmcnt(0)" ::: "memory");
        }
    }
    __syncthreads();
}
namespace att {
constexpr int SHM_K = 16384, SHM_V = 16384;
constexpr float SM_THR = 8.0f;
#define KSWZ(row, colB) ((row) * 256 + ((colB) ^ (((row) & 7) << 4)))
#define SBAR() __builtin_amdgcn_sched_barrier(0)
__device__ __forceinline__ int v_st(int k, int c) { const int kk = (k & ~0xC) | ((k & 4) << 1) | ((k & 8) >> 1); return ((kk >> 3) * 4 + (c >> 5)) * 512 + ((kk & 7) * 32 + (c & 31)) * 2; }
__device__ __forceinline__ int v_rd_base(int lane) { return ((lane & 3) << 3) | (((lane >> 2) & 3) << 6) | (((lane >> 4) & 1) << 5) | (((lane >> 5) & 1) << 8); }
constexpr int v_rd_off(int d0, int ks, int half) { return d0 * 512 + ks * 4096 + half * 2048; }
__device__ __forceinline__ int crow(int r, int hi) { return (r & 3) + 8 * (r >> 2) + 4 * hi; }
__device__ __forceinline__ unsigned cvtpk(float lo, float hi) { unsigned r; asm volatile("v_cvt_pk_bf16_f32 %0, %1, %2" : "=v"(r) : "v"(lo), "v"(hi)); return r; }

__device__ __forceinline__ void qkt(f32x16& p0, f32x16& p1, const LAS char* Kb, int r32, int hi, const bf16x8* qr) {
    p0 = f32x16{}; p1 = f32x16{};
    int ka[4];
#pragma unroll
    for (int dd = 0; dd < 4; ++dd) ka[dd] = (int)(unsigned)(uintptr_t)(Kb + KSWZ(r32, (dd * 16 + hi * 8) * 2));
#define DSR128(dst, addr, off) asm volatile("ds_read_b128 %0, %1 offset:%2" : "=v"(dst) : "v"(addr), "i"(off) : "memory")
    bf16x8 kf[8];
#pragma unroll
    for (int hf = 0; hf < 2; ++hf) {
#pragma unroll
        for (int dd = 0; dd < 4; ++dd) { if (hf == 0) { DSR128(kf[2 * dd], ka[dd], 0); DSR128(kf[2 * dd + 1], ka[dd], 8192); } else { DSR128(kf[2 * dd], ka[dd], 128); DSR128(kf[2 * dd + 1], ka[dd], 8192 + 128); } }
        asm volatile("s_waitcnt lgkmcnt(0)" ::: "memory"); SBAR();
#pragma unroll
        for (int dd = 0; dd < 4; ++dd) {
            p0 = __builtin_amdgcn_mfma_f32_32x32x16_bf16(kf[2 * dd], qr[4 * hf + dd], p0, 0, 0, 0);
            p1 = __builtin_amdgcn_mfma_f32_32x32x16_bf16(kf[2 * dd + 1], qr[4 * hf + dd], p1, 0, 0, 0); }
        SBAR();
    }
#undef DSR128
}
__device__ __forceinline__ void pv_tile(f32x16* o, int vb0, bf16x8 pa0, bf16x8 pa1, bf16x8 pa2, bf16x8 pa3) {
#define TRRD(dst, off) asm volatile("ds_read_b64_tr_b16 %0, %1 offset:%2" : "=&v"(dst) : "v"(vb0), "i"(off) : "memory")
#define PV_RD(S, d0) do { constexpr int b_ = v_rd_off(d0, 0, 0); \
        TRRD(S##l0, b_); TRRD(S##h0, b_ + 2048); TRRD(S##l1, b_ + 4096); TRRD(S##h1, b_ + 6144); TRRD(S##l2, b_ + 8192); TRRD(S##h2, b_ + 10240); TRRD(S##l3, b_ + 12288); TRRD(S##h3, b_ + 14336); } while (0)
#define PV_MM(S, d0) do { \
        o[d0] = __builtin_amdgcn_mfma_f32_32x32x16_bf16(pa0, (bf16x8){S##l0[0], S##l0[1], S##l0[2], S##l0[3], S##h0[0], S##h0[1], S##h0[2], S##h0[3]}, o[d0], 0, 0, 0);   \
        o[d0] = __builtin_amdgcn_mfma_f32_32x32x16_bf16(pa1, (bf16x8){S##l1[0], S##l1[1], S##l1[2], S##l1[3], S##h1[0], S##h1[1], S##h1[2], S##h1[3]}, o[d0], 0, 0, 0);   \
        o[d0] = __builtin_amdgcn_mfma_f32_32x32x16_bf16(pa2, (bf16x8){S##l2[0], S##l2[1], S##l2[2], S##l2[3], S##h2[0], S##h2[1], S##h2[2], S##h2[3]}, o[d0], 0, 0, 0);   \
        o[d0] = __builtin_amdgcn_mfma_f32_32x32x16_bf16(pa3, (bf16x8){S##l3[0], S##l3[1], S##l3[2], S##l3[3], S##h3[0], S##h3[1], S##h3[2], S##h3[3]}, o[d0], 0, 0, 0); } while (0)
#define PV_W8() do { asm volatile("s_waitcnt lgkmcnt(8)" ::: "memory"); SBAR(); } while (0)
#define PV_W0() do { asm volatile("s_waitcnt lgkmcnt(0)" ::: "memory"); SBAR(); } while (0)
    s16x4 Al0, Al1, Al2, Al3, Ah0, Ah1, Ah2, Ah3, Bl0, Bl1, Bl2, Bl3, Bh0, Bh1, Bh2, Bh3;
    PV_RD(A, 0); SBAR(); PV_RD(B, 1); PV_W8(); PV_MM(A, 0); SBAR();
    PV_RD(A, 2); PV_W8(); PV_MM(B, 1); SBAR();
    PV_RD(B, 3); PV_W8(); PV_MM(A, 2); SBAR();
    PV_W0(); PV_MM(B, 3);
#undef PV_RD
#undef PV_MM
#undef PV_W8
#undef PV_W0
#undef TRRD
}
__device__ __forceinline__ void pack_p(const f32x16& p0, const f32x16& p1, bf16x8& pa0, bf16x8& pa1, bf16x8& pa2, bf16x8& pa3) {
#define PK4(P, B_, OUT) do { unsigned a0 = cvtpk(P[B_+0], P[B_+1]), a1 = cvtpk(P[B_+2], P[B_+3]);                          \
        unsigned b0 = cvtpk(P[B_+4], P[B_+5]), b1 = cvtpk(P[B_+6], P[B_+7]);                                             \
        auto r0 = __builtin_amdgcn_permlane32_swap(a0, b0, false, false); auto r1 = __builtin_amdgcn_permlane32_swap(a1, b1, false, false); \
        u32x4 w = {r0[0], r1[0], r0[1], r1[1]}; OUT = *reinterpret_cast<bf16x8*>(&w); } while (0)
    PK4(p0, 0, pa0); PK4(p0, 8, pa1); PK4(p1, 0, pa2); PK4(p1, 8, pa3);
#undef PK4
}
__device__ __forceinline__ float xhalf_max(float v) { auto rr = __builtin_amdgcn_permlane32_swap(__float_as_uint(v), __float_as_uint(v), false, false); return fmaxf(__uint_as_float(rr[0]), __uint_as_float(rr[1])); }
__device__ __forceinline__ float xhalf_sum(float v) { auto rr = __builtin_amdgcn_permlane32_swap(__float_as_uint(v), __float_as_uint(v), false, false); return __uint_as_float(rr[0]) + __uint_as_float(rr[1]); }

template <bool USE_TAB>
__device__ __forceinline__ void xform(f32x16& p0, f32x16& p1, int dq0, unsigned W, bool rowok, float cb, const LAS float* tab  ) {
    const float NEG = -__builtin_inff();
#pragma unroll
    for (int q = 0; q < 4; ++q) {
        const int db0 = dq0 - 8 * q, db1 = db0 - 32;
        float b0[4] = {cb, cb, cb, cb}, b1[4] = {cb, cb, cb, cb};
        if (USE_TAB) {
            const int c0 = db0 < 0 ? 0 : (db0 > 130 ? 130 : db0), c1 = db1 < 0 ? 0 : (db1 > 130 ? 130 : db1);
            const LAS float* t0 = tab + c0; const LAS float* t1 = tab + c1;
#pragma unroll
            for (int e = 0; e < 4; ++e) { b0[e] = t0[3 - e]; b1[e] = t1[3 - e]; asm volatile("" : "+v"(b0[e]), "+v"(b1[e])); }
        }
#pragma unroll
        for (int e = 0; e < 4; ++e) { const int r = 4 * q + e;
            p0[r] = (rowok && (unsigned)(db0 - e) < W) ? p0[r] + b0[e] : NEG;
            p1[r] = (rowok && (unsigned)(db1 - e) < W) ? p1[r] + b1[e] : NEG; }

    }
}
__device__ __forceinline__ void sm_step_c(f32x16& p0, f32x16& p1, float& l, bf16x8& pa0, bf16x8& pa1, bf16x8& pa2, bf16x8& pa3, float off) {
    float ps = 0.f;
#pragma unroll
    for (int r = 0; r < 16; ++r) { p0[r] = __builtin_amdgcn_exp2f(p0[r] + off); p1[r] = __builtin_amdgcn_exp2f(p1[r] + off); ps += p0[r] + p1[r]; }
    ps = xhalf_sum(ps);
    l += ps;
    pack_p(p0, p1, pa0, pa1, pa2, pa3);
}
template <int ND4>
__device__ __forceinline__ void scale_rows(f32x16* o, float f, LAS float* wscr  , int r32, int hi) {
    if (hi == 0) wscr[r32] = f;
    asm volatile("s_waitcnt lgkmcnt(0)" ::: "memory");
    float fr[16];
#pragma unroll
    for (int r = 0; r < 16; ++r) fr[r] = wscr[crow(r, hi)];
#pragma unroll
    for (int d = 0; d < ND4; ++d)
#pragma unroll
        for (int r = 0; r < 16; ++r) o[d][r] *= fr[r];
    asm volatile("s_waitcnt lgkmcnt(0)" ::: "memory");
}
__device__ __forceinline__ int k_dma_off(int wave, int lane, int ldk) { const int row = wave * 4 + (lane >> 4); const int ch = (lane & 15) ^ (row & 7); return row * ldk + ch * 8; }
__device__ __forceinline__ int v_dma_off(int wave, int lane, int ldv) { const int st = wave * 2 + (lane >> 5); const int kk = (st >> 2) * 8 + ((lane & 31) >> 2);
    const int k = (kk & ~0xC) | ((kk & 4) << 1) | ((kk & 8) >> 1); const int c = (st & 3) * 32 + (lane & 3) * 8; return k * ldv + c; }
__device__ __forceinline__ void glds16(const bf16* src, LAS char* dst) { __builtin_amdgcn_global_load_lds((const unsigned*)src, (LAS unsigned*)dst, 16, 0, 0); }
template <int NV>
__device__ __forceinline__ void tile_dma(const bf16* Kt, int ldk, const bf16* Vt, int ldv, int kofs, int vofs, LAS char* Kb, LAS char* Vb, int wave) {
    glds16(Kt + kofs, Kb + wave * 1024); glds16(Kt + kofs + 32 * ldk, Kb + 8192 + wave * 1024);
    glds16(Vt + vofs, Vb + wave * 1024); glds16(Vt + vofs + 32 * ldv, Vb + 8192 + wave * 1024);
    if (NV == 2) { glds16(Vt + 128 + vofs, Vb + SHM_V + wave * 1024); glds16(Vt + 128 + vofs + 32 * ldv, Vb + SHM_V + 8192 + wave * 1024); }
}
struct Stage1 { bf16x8 k0, k1, v0, v1; };
__device__ __forceinline__ void stage_load(Stage1& S, const bf16* Kp, const bf16* Vp, int sr, int sc) {
    S.k0 = *(const bf16x8*)(Kp + sr * 128 + sc); S.k1 = *(const bf16x8*)(Kp + (sr + 32) * 128 + sc);
    S.v0 = *(const bf16x8*)(Vp + sr * 128 + sc); S.v1 = *(const bf16x8*)(Vp + (sr + 32) * 128 + sc);
}
__device__ __forceinline__ void stage_write(const Stage1& S, LAS char* Kb, LAS char* Vb, int kws, int vst0, int vst1) {
    *(LAS bf16x8*)(Kb + kws) = S.k0; *(LAS bf16x8*)(Kb + kws + 32 * 256) = S.k1;
    *(LAS bf16x8*)(Vb + vst0) = S.v0; *(LAS bf16x8*)(Vb + vst1) = S.v1;
}
}

constexpr int BT_STRIDE = 136;
__device__ __forceinline__ float wave_max(float v) {
#pragma unroll
    for (int o = 1; o < 64; o <<= 1) v = fmaxf(v, __shfl_xor(v, o));
    return v;
}
__device__ __forceinline__ void build_bias(ArgP a, LAS float* tab, int tid) {
    const float* rel_bias = a->in[24];
    for (int i = tid; i < 12 * BT_STRIDE; i += NTHR) { const int hd = i / BT_STRIDE, x = i % BT_STRIDE; int d = x - 3; d = d < 0 ? 0 : (d > 127 ? 127 : d); tab[i] = rel_bias[T5_BUCKET[d] * 12 + hd] * LOG2E; }
    if (tid < 64) {
        const float* gq = a->in[7]; const float* gk = a->in[8]; const float* dq = a->in[12]; const float* dk = a->in[13];
        const float mq = wave_max(fmaxf(fabsf(gq[tid]), fabsf(gq[64 + tid]))), mdq = wave_max(fmaxf(fabsf(dq[tid]), fabsf(dq[64 + tid]))), mdk = wave_max(fmaxf(fabsf(dk[tid]), fabsf(dk[64 + tid])));
        const float mk0 = wave_max(fmaxf(fabsf(gk[tid]), fabsf(gk[64 + tid]))), mk1 = wave_max(fmaxf(fabsf(gk[128 + tid]), fabsf(gk[192 + tid]))), mk2 = wave_max(fmaxf(fabsf(gk[256 + tid]), fabsf(gk[320 + tid])));
        float mb = 0.f; for (int i = tid; i < 384; i += 64) mb = fmaxf(mb, fabsf(rel_bias[i])); mb = wave_max(mb) * LOG2E + 1.0f;
        const float K = 1.03f * 128.0f * QSCALE;
        LAS float* cbv = tab + 12 * BT_STRIDE;
        if (tid == 0) { cbv[0] = fminf(K * mdq * mdk + mb, 100.f); cbv[1] = fminf(K * mq * mk0 + mb, 100.f); cbv[2] = fminf(K * mq * mk1 + mb, 100.f); cbv[3] = fminf(K * mq * mk2 + mb, 100.f); }
    }
}

__device__ __forceinline__ void diff_item(ArgP a, LAS unsigned char* lds_g, int item, int tid, int lane, int wave) {
    using namespace att;
    unsigned char* ws = a->ws;
    const int qi = 15 - (item >> 5), rest = item & 31, mp = rest & 1, h = (rest >> 1) & 3, b = rest >> 3;
    const int r32 = lane & 31, hi = lane >> 5, rg = wave >> 1, vh = wave & 1;
    const bf16* DQ = (const bf16*)(ws + WS_DQ); const bf16* DK = (const bf16*)(ws + WS_DK); const bf16* DV = (const bf16*)(ws + WS_DV);
    float* On = (float*)(ws + WS_DTMP) + (size_t)mp * NM * 1024;
    const int tq = qi * 128 + rg * 32 + r32;
    const size_t rowbase = (size_t)b * NT;
    bf16x8 qr[8];
    { const bf16* qp = DQ + ((size_t)(h * 2 + mp) * NM + rowbase + tq) * 128 + hi * 8;
#pragma unroll
      for (int d0 = 0; d0 < 8; ++d0) qr[d0] = *(const bf16x8*)(qp + d0 * 16); }
    const bf16* Kg = DK + ((size_t)(h * 2 + mp) * NM + rowbase) * 128;
    const bf16* Vg = DV + ((size_t)h * NM + rowbase) * 256;
    const int kofs = k_dma_off(wave, lane, 128), vofs = v_dma_off(wave, lane, 256);
    LAS char* L = (LAS char*)lds_g;
    LAS float* wscr = (LAS float*)(L + A_WSCR) + wave * 64;
    const LAS float* tab = (const LAS float*)(L + A_BIAS) + (8 + h) * BT_STRIDE;
    const float cb = tab[130];
    const float CB = ((const LAS float*)(L + A_BIAS))[12 * BT_STRIDE + 0];
    const int vrb = v_rd_base(lane) + vh * SHM_V;
    LAS char* PX = L + A_VBUF + 4 * SHM_V + rg * 4096 + lane * 64;
    f32x16 o[4];
#pragma unroll
    for (int d = 0; d < 4; ++d) o[d] = f32x16{};
    float l = 0.f;
    const int NTI = 2 * qi + 2;
#define DMA_K(t_, s_) do { glds16(Kg + (size_t)(t_) * 64 * 128 + kofs, L + A_KBUF + (s_) * SHM_K + wave * 1024); glds16(Kg + (size_t)(t_) * 64 * 128 + kofs + 32 * 128, L + A_KBUF + (s_) * SHM_K + 8192 + wave * 1024); } while (0)
#define DMA_V(t_, s_) do { const bf16* vt_ = Vg + (size_t)(t_) * 64 * 256 + vofs; LAS char* vb_ = L + A_VBUF + (s_) * 2 * SHM_V + wave * 1024; \
        glds16(vt_, vb_); glds16(vt_ + 32 * 256, vb_ + 8192); glds16(vt_ + 128, vb_ + SHM_V); glds16(vt_ + 128 + 32 * 256, vb_ + SHM_V + 8192); } while (0)
    DMA_K(0, 0); DMA_V(0, 0); DMA_K(1, 1);
#pragma unroll
    for (int d0 = 0; d0 < 8; ++d0) asm volatile("" : "+v"(qr[d0]));
    bf16x8 pk0 = {}, pk1 = {}, pk2 = {}, pk3 = {};
    for (int t = 0; t <= NTI; ++t) {
        if (t == 0) asm volatile("s_waitcnt vmcnt(6)" ::: "memory");
        else if (t + 1 < NTI) asm volatile("s_waitcnt vmcnt(2)" ::: "memory");
        else asm volatile("s_waitcnt vmcnt(0)" ::: "memory");
        __builtin_amdgcn_s_barrier(); asm volatile("" ::: "memory");
        if (t >= 1 && t < NTI) DMA_V(t, t & 1);
        if (t + 2 < NTI) DMA_K(t + 2, (t + 2) % 3);
        const bool prod = (t < NTI) && ((((t + (rg >> 1)) & 1)) == vh);
        const bool prev_mine = (t >= 1) && ((((t - 1 + (rg >> 1)) & 1)) == vh);
        bf16x8 pa0 = pk0, pa1 = pk1, pa2 = pk2, pa3 = pk3;
        if (t >= 1 && !prev_mine) { pa0 = *(const LAS bf16x8*)(PX); pa1 = *(const LAS bf16x8*)(PX + 16); pa2 = *(const LAS bf16x8*)(PX + 32); pa3 = *(const LAS bf16x8*)(PX + 48);
            asm volatile("s_waitcnt lgkmcnt(0)" ::: "memory"); }
        if (prod) {
            f32x16 p0, p1;
            qkt(p0, p1, L + A_KBUF + (t % 3) * SHM_K, r32, hi, qr);
            float cbias = cb;
            if (t >= 2 * qi - 2) { xform<true>(p0, p1, tq - t * 64 - 4 * hi, 0x7fffffffu, true, cb, tab); cbias = 0.f; }
            sm_step_c(p0, p1, l, pk0, pk1, pk2, pk3, cbias - CB);
            *(LAS bf16x8*)(PX) = pk0; *(LAS bf16x8*)(PX + 16) = pk1; *(LAS bf16x8*)(PX + 32) = pk2; *(LAS bf16x8*)(PX + 48) = pk3;
            asm volatile("s_waitcnt lgkmcnt(0)" ::: "memory");
        }
        if (t >= 1) pv_tile(o, (int)(unsigned)(uintptr_t)(L + A_VBUF + ((t - 1) & 1) * 2 * SHM_V) + vrb, pa0, pa1, pa2, pa3);
    }
#undef DMA_K
#undef DMA_V
    if (hi == 0) wscr[32 + r32] = l;
    asm volatile("s_waitcnt lgkmcnt(0)" ::: "memory"); __builtin_amdgcn_s_barrier(); asm volatile("" ::: "memory");
    { const LAS float* pw = (const LAS float*)(L + A_WSCR) + (wave ^ 1) * 64; l += pw[32 + r32]; }
    scale_rows<4>(o, 1.0f / l, wscr, r32, hi);
    unsigned ob = (unsigned)((rowbase + qi * 128 + rg * 32 + 4 * hi) * 1024 + h * 256 + vh * 128 + r32); asm volatile("" : "+v"(ob));
#pragma unroll
    for (int r = 0; r < 16; ++r) { float* rp = On + ((size_t)ob + (unsigned)(((r & 3) + 8 * (r >> 2)) * 1024));
#pragma unroll
        for (int d = 0; d < 4; ++d) rp[d * 32] = o[d][r]; }
}

__device__ __forceinline__ void compress_item(ArgP a, LAS unsigned char* lds_g, int item, int tid, int lane, int wave) {
    unsigned char* ws = a->ws;
    const int i = item >> 5, rb = item & 31;
    const int r32 = lane & 31, hi = lane >> 5, ct = wave & 3, kh = wave >> 2;
    const bf16* KV = (const bf16*)(ws + WS_KV); const bf16* W1T = (const bf16*)(ws + WS_WC1) + (size_t)i * 128 * 4096;
    LAS char* L = (LAS char*)lds_g;
    LAS float* red = (LAS float*)L;
    LAS float* hb = (LAS float*)(L + 16384);
    LAS float* cv = (LAS float*)(L + 32768);
    if (tid < 128) { const float* cp = (const float*)(ws + WS_SMALL + SM_CPART) + i * 128 + tid; float s = 0.f; for (int kc = 0; kc < 32; ++kc) s += cp[kc * 256]; cv[tid] = s; }
    int R = rb * 32 + r32; if (R > 1015) R = 1015;
    const int b = R / 254, rem = R % 254, c = rem >> 1, g = rem & 1;
    const bf16* ap = KV + ((size_t)(i * 2 + g) * NM + (size_t)b * NT + 16 * c + 16 * kh) * 128 + 8 * hi;
    const bf16* bp = W1T + (size_t)(32 * ct + r32) * 4096 + 2048 * kh + 8 * hi;
    f32x16 acc = f32x16{};
#pragma unroll 8
    for (int kk = 0; kk < 128; ++kk) {
        const bf16x8 af = *(const bf16x8*)(ap + (size_t)(kk >> 3) * 128 + (kk & 7) * 16);
        const bf16x8 bf = *(const bf16x8*)(bp + kk * 16);
        acc = __builtin_amdgcn_mfma_f32_32x32x16_bf16(af, bf, acc, 0, 0, 0);
    }
    if (kh == 1) {
#pragma unroll
        for (int r = 0; r < 16; ++r) red[(ct * 16 + r) * 64 + lane] = acc[r]; }
    __syncthreads();
    if (kh == 0) {
#pragma unroll
        for (int r = 0; r < 16; ++r) { const float v = acc[r] + red[(ct * 16 + r) * 64 + lane] + cv[32 * ct + r32];
            hb[att::crow(r, hi) * 128 + 32 * ct + r32] = gelu_tanh_(v); } }
    __syncthreads();
    const int row = tid >> 4, n2 = (tid & 15) * 8;
    const float* w2 = a->in[11] + (size_t)i * 128 * 128 + n2;
    f32x4 s0 = {0, 0, 0, 0}, s1 = s0;
#pragma unroll 4
    for (int n = 0; n < 128; ++n) { const float hv = hb[row * 128 + n]; s0 += *(const f32x4*)(w2 + n * 128) * hv; s1 += *(const f32x4*)(w2 + n * 128 + 4) * hv; }
    if (i == 0) {
        float ss = (s0[0] * s0[0] + s0[1] * s0[1]) + (s0[2] * s0[2] + s0[3] * s0[3]) + (s1[0] * s1[0] + s1[1] * s1[1]) + (s1[2] * s1[2] + s1[3] * s1[3]);
        ss += __shfl_xor(ss, 1); ss += __shfl_xor(ss, 2); ss += __shfl_xor(ss, 4); ss += __shfl_xor(ss, 8);
        const float rs = rsqrtf(ss * (1.0f / 128.0f) + EPSF);
        const f32x4 g0 = *(const f32x4*)(a->in[8] + n2), g1 = *(const f32x4*)(a->in[8] + n2 + 4);
        s0 = s0 * rs * g0; s1 = s1 * rs * g1;
    }
    const int Ro = rb * 32 + row;
    if (Ro < 1016) { const int bo = Ro / 254, remo = Ro % 254, co = remo >> 1, go = remo & 1;
        bf16* dst = (bf16*)(ws + WS_SMALL + (i == 0 ? SM_KC : SM_VC)) + ((size_t)(bo * 2 + go) * 128 + co) * 128 + n2;
        pg8::st8_bf16(dst, s0, s1); }
    __syncthreads();
}

__device__ __forceinline__ void phase3(ArgP a, LAS unsigned char* lds, int tid, int lane, int wave) {
    LAS unsigned char* lds_g = lds;
    build_bias(a, (LAS float*)(lds_g + A_BIAS), tid);
    unsigned* ctr = (unsigned*)(a->ws + WS_SMALL + SM_QCTR);
    volatile LAS unsigned* slot = (volatile LAS unsigned*)(lds_g + MISC_OFF + 16);
    if (tid == 0) slot[0] = __hip_atomic_fetch_add(ctr, 1u, __ATOMIC_RELAXED, __HIP_MEMORY_SCOPE_AGENT);
    __syncthreads();
    int idx = (int)slot[0];
    while (idx < 512 + 64) {
        unsigned nxt = 0;
        if (tid == 0) nxt = __hip_atomic_fetch_add(ctr, 1u, __ATOMIC_RELAXED, __HIP_MEMORY_SCOPE_AGENT);
        if (idx >= 416 && idx < 480) compress_item(a, lds_g, idx - 416, tid, lane, wave);
        else diff_item(a, lds_g, idx < 416 ? idx : idx - 64, tid, lane, wave);
        if (tid == 0) slot[0] = nxt;
        asm volatile("s_waitcnt lgkmcnt(0)" ::: "memory"); __builtin_amdgcn_s_barrier(); asm volatile("" ::: "memory");
        idx = (int)slot[0];
    }
}

#define NSA_SETUP \
    using namespace att; \
    unsigned char* ws = a->ws; \
    int lane = lane_in; asm volatile("" : "+v"(lane)); int tid = tid_in; asm volatile("" : "+v"(tid)); \
    const int ci = 31 - (item & 31), g = (item >> 5) & 1, b = item >> 6; \
    const int r32 = lane & 31, hi = lane >> 5, hh = wave >> 1, hd = g * 4 + hh; \
    const int tl = 32 * (wave & 1) + r32, tq = ci * 64 + tl; \
    const size_t rowbase = (size_t)b * NT; \
    const bf16* QN = (const bf16*)(ws + WS_QN); const bf16* KV = (const bf16*)(ws + WS_KV); \
    const float* Gt = (const float*)(ws + WS_SMALL + SM_G) + (rowbase + tq) * 24 + hd * 3; \
    float* TMP = (float*)(ws + WS_NSATMP); bf16* ONSA = (bf16*)(ws + WS_ONSA); \
    LAS char* L = (LAS char*)lds_g; \
    LAS float* wscr = (LAS float*)(L + A_WSCR) + wave * 64; \
    const LAS float* tab = (const LAS float*)(L + A_BIAS) + hd * BT_STRIDE; \
    const float cb = tab[130]; \
    LAS float* scb = (LAS float*)(L + A_SC); \
    LAS unsigned* smask = (LAS unsigned*)(L + A_SMASK); LAS unsigned* un = (LAS unsigned*)(L + A_UN); \
    const int kofs = k_dma_off(wave, lane, 128), vofs = v_dma_off(wave, lane, 128); \
    const int vrb = v_rd_base(lane); \
    const unsigned obase0 = (unsigned)((rowbase + ci * 64 + 32 * (wave & 1) + 4 * hi) * 1024 + hd * 128 + r32); \
    (void)QN; (void)KV; (void)Gt; (void)TMP; (void)ONSA; (void)wscr; (void)tab; (void)cb; (void)scb; (void)smask; (void)un; (void)kofs; (void)vofs; (void)vrb; (void)obase0; (void)tq; (void)tl; (void)tid;
#define NSA_LOADQ bf16x8 qr[8]; { const bf16* qp = QN + ((size_t)hd * NM + rowbase + tq) * 128 + hi * 8; _Pragma("unroll") for (int d0 = 0; d0 < 8; ++d0) qr[d0] = *(const bf16x8*)(qp + d0 * 16); _Pragma("unroll") for (int d0 = 0; d0 < 8; ++d0) asm volatile("" : "+v"(qr[d0])); }
#define OROW(r) ((size_t)ob + (unsigned)((((r) & 3) + 8 * ((r) >> 2)) * 1024))
#define IMPP(h_, t_) ((LAS float*)(L + ((h_) < 2 ? A_IMPP : A_IMPP2)) + ((((h_) & 1) * 64 + (t_)) * 32))
__device__ __forceinline__ void nsa_b1(ArgP a, LAS unsigned char* lds_g, int item, int tid_in, int lane_in, int wave) {
    NSA_SETUP
    NSA_LOADQ
    f32x16 o[4]; (void)o;
    {
        const bf16* KC = (const bf16*)(ws + WS_SMALL + SM_KC) + (size_t)(b * 2 + g) * 128 * 128;
        const bf16* VC = (const bf16*)(ws + WS_SMALL + SM_VC) + (size_t)(b * 2 + g) * 128 * 128;
        if (tid < 64) smask[tid] = 0u; if (tid == 64) un[0] = 0u;
        { const int kc_ofs = k_dma_off(wave, lane, 128), vc_ofs = v_dma_off(wave, lane, 128);
#pragma unroll
          for (int tt = 0; tt < 2; ++tt) tile_dma<1>(KC + tt * 64 * 128, 128, VC + tt * 64 * 128, 128, kc_ofs, vc_ofs, L + A_KBUF + tt * SHM_K, L + A_VBUF + tt * 2 * SHM_V, wave); }
        __syncthreads();
        f32x16 pA0, pA1, pB0, pB1;
        qkt(pA0, pA1, L + A_KBUF, r32, hi, qr);
        qkt(pB0, pB1, L + A_KBUF + SHM_K, r32, hi, qr);
        const float NEG = -__builtin_inff();
        float pmax = NEG;
#define CMPX(P, coff) { _Pragma("unroll") for (int r = 0; r < 16; ++r) { const int d = tq - 31 - 16 * (crow(r, hi) + (coff)); const int ix = d > 127 ? 127 : (d < 0 ? 0 : d); float bv = tab[ix + 3]; asm volatile("" : "+v"(bv)); P[r] = d >= 0 ? P[r] + bv : NEG; pmax = fmaxf(pmax, P[r]); } }
        CMPX(pA0, 0) CMPX(pA1, 32) CMPX(pB0, 64) CMPX(pB1, 96)
#undef CMPX
        pmax = xhalf_max(pmax);
        const float mm = fmaxf(pmax, -1e30f);
        float ps = 0.f;
#pragma unroll
        for (int r = 0; r < 16; ++r) { pA0[r] = __builtin_amdgcn_exp2f(pA0[r] - mm); pA1[r] = __builtin_amdgcn_exp2f(pA1[r] - mm); pB0[r] = __builtin_amdgcn_exp2f(pB0[r] - mm); pB1[r] = __builtin_amdgcn_exp2f(pB1[r] - mm);
            ps += (pA0[r] + pA1[r]) + (pB0[r] + pB1[r]); }
        ps = xhalf_sum(ps);
        const float inv = ps > 0.f ? 1.0f / ps : 0.f;
#pragma unroll
        for (int r = 0; r < 16; ++r) { pA0[r] *= inv; pA1[r] *= inv; pB0[r] *= inv; pB1[r] *= inv; }
        {
            float dsum[16], p3[16];
#pragma unroll
            for (int q = 0; q < 4; ++q) {
                dsum[0 + q]  = 2.f * (pA0[4 * q] + pA0[4 * q + 1] + pA0[4 * q + 2]) + pA0[4 * q + 3]; p3[0 + q]  = pA0[4 * q + 3];
                dsum[4 + q]  = 2.f * (pA1[4 * q] + pA1[4 * q + 1] + pA1[4 * q + 2]) + pA1[4 * q + 3]; p3[4 + q]  = pA1[4 * q + 3];
                dsum[8 + q]  = 2.f * (pB0[4 * q] + pB0[4 * q + 1] + pB0[4 * q + 2]) + pB0[4 * q + 3]; p3[8 + q]  = pB0[4 * q + 3];
                dsum[12 + q] = 2.f * (pB1[4 * q] + pB1[4 * q + 1] + pB1[4 * q + 2]) + pB1[4 * q + 3]; p3[12 + q] = pB1[4 * q + 3];
            }
            LAS float* ip = IMPP(hh, tl);
#pragma unroll
            for (int G = 0; G < 16; ++G) {
                const float oth = __shfl_xor(p3[G], 32);
                const float othm = G > 0 ? __shfl_xor(p3[G > 0 ? G - 1 : 0], 32) : 0.f;
                ip[2 * G + hi] = dsum[G] + (hi ? oth : othm);
            }
        }
        bf16x8 pa0, pa1, pa2, pa3, pb0, pb1, pb2, pb3;
        pack_p(pA0, pA1, pa0, pa1, pa2, pa3); pack_p(pB0, pB1, pb0, pb1, pb2, pb3);
#pragma unroll
        for (int d = 0; d < 4; ++d) o[d] = f32x16{};
        pv_tile(o, (int)(unsigned)(uintptr_t)(L + A_VBUF) + vrb, pa0, pa1, pa2, pa3);
        pv_tile(o, (int)(unsigned)(uintptr_t)(L + A_VBUF + 2 * SHM_V) + vrb, pb0, pb1, pb2, pb3);
        scale_rows<4>(o, Gt[0], wscr, r32, hi);
        unsigned ob = obase0; asm volatile("" : "+v"(ob));
#pragma unroll
        for (int r = 0; r < 16; ++r) { float* rp = TMP + OROW(r);
#pragma unroll
            for (int d = 0; d < 4; ++d) rp[d * 32] = o[d][r]; }
    }
}
__device__ __forceinline__ void nsa_sel(ArgP a, LAS unsigned char* lds_g, int item, int tid_in, int lane_in, int wave) {
    NSA_SETUP
    f32x16 o[4]; (void)o;
    __syncthreads();
    {
        const int t = tid >> 3, jq = tid & 7;
        float sv[4];
#pragma unroll
        for (int e = 0; e < 4; ++e) { const int j = jq * 4 + e;
            const float imp = (IMPP(0, t)[j] + IMPP(1, t)[j]) + (IMPP(2, t)[j] + IMPP(3, t)[j]);
            const bool forced = (j == 0) || (j == ci) || (j == ci - 1);
            sv[e] = forced ? 1e4f : (j <= ci ? imp : -1e4f);
            scb[t * 33 + j] = sv[e]; }
        __syncthreads();
        unsigned bits = 0u;
#pragma unroll
        for (int e = 0; e < 4; ++e) { const int j = jq * 4 + e; int cnt = 0;
#pragma unroll 1
            for (int jj = 0; jj < 32; ++jj) { const float x = scb[t * 33 + jj]; cnt += (x > sv[e] || (x == sv[e] && jj < j)) ? 1 : 0; }
            if (cnt < 16) bits |= 1u << j; }
        __hip_atomic_fetch_or(&smask[t], bits, __ATOMIC_RELAXED, __HIP_MEMORY_SCOPE_WORKGROUP); __hip_atomic_fetch_or(&un[0], bits, __ATOMIC_RELAXED, __HIP_MEMORY_SCOPE_WORKGROUP);
        __syncthreads();
    }
}
__device__ __forceinline__ void nsa_b2(ArgP a, LAS unsigned char* lds_g, int item, int tid_in, int lane_in, int wave) {
    NSA_SETUP
    NSA_LOADQ
    f32x16 o[4]; (void)o;
    const unsigned mymask = smask[tl], umask = un[0];
    {
        const bf16* Kg = KV + ((size_t)(2 * 2 + g) * NM + rowbase) * 128;
        const bf16* Vg = KV + ((size_t)(3 * 2 + g) * NM + rowbase) * 128;
#pragma unroll
        for (int d = 0; d < 4; ++d) o[d] = f32x16{};
        float l = 0.f;
        const float CB = ((const LAS float*)(L + A_BIAS))[12 * BT_STRIDE + 2];
        unsigned rem = umask & (ci >= 31 ? 0xffffffffu : ((2u << ci) - 1u));
            int j = rem ? __builtin_ctz(rem) : -1;
        rem &= rem - 1;
        int j1 = rem ? __builtin_ctz(rem) : -1;
        tile_dma<1>(Kg + (size_t)j * 64 * 128, 128, Vg + (size_t)j * 64 * 128, 128, kofs, vofs, L + A_KBUF, L + A_VBUF, wave);
        if (j1 >= 0) { rem &= rem - 1; tile_dma<1>(Kg + (size_t)j1 * 64 * 128, 128, Vg + (size_t)j1 * 64 * 128, 128, kofs, vofs, L + A_KBUF + SHM_K, L + A_VBUF + 2 * SHM_V, wave); }
        int st = 0;
        while (j >= 0) {
            if (j1 >= 0) asm volatile("s_waitcnt vmcnt(4)" ::: "memory"); else asm volatile("s_waitcnt vmcnt(0)" ::: "memory");
            __builtin_amdgcn_s_barrier(); asm volatile("" ::: "memory");
            LAS char* Kb = L + A_KBUF + st * SHM_K; LAS char* Vb = L + A_VBUF + st * 2 * SHM_V;
            const int st2 = st == 0 ? 2 : st - 1;
            int j2 = -1;
            if (rem) { j2 = __builtin_ctz(rem); rem &= rem - 1;
                tile_dma<1>(Kg + (size_t)j2 * 64 * 128, 128, Vg + (size_t)j2 * 64 * 128, 128, kofs, vofs, L + A_KBUF + st2 * SHM_K, L + A_VBUF + st2 * 2 * SHM_V, wave); }
            f32x16 p0, p1;
            qkt(p0, p1, Kb, r32, hi, qr);
            const bool rowok = (mymask >> j) & 1u; float cbias = cb;
            if (j >= ci - 2) { xform<true>(p0, p1, tq - j * 64 - 4 * hi, 0x7fffffffu, rowok, cb, tab); cbias = 0.f; }
            bf16x8 pa0, pa1, pa2, pa3;
            sm_step_c(p0, p1, l, pa0, pa1, pa2, pa3, rowok ? cbias - CB : -__builtin_inff());
            pv_tile(o, (int)(unsigned)(uintptr_t)Vb + vrb, pa0, pa1, pa2, pa3);
            j = j1; j1 = j2; st = st == 2 ? 0 : st + 1;
        }
        __builtin_amdgcn_s_barrier();
        scale_rows<4>(o, l > 0.f ? Gt[1] / l : 0.f, wscr, r32, hi);
        unsigned ob = obase0; asm volatile("" : "+v"(ob));
#pragma unroll
        for (int r = 0; r < 16; ++r) { float* rp = TMP + OROW(r);
#pragma unroll
            for (int d = 0; d < 4; ++d) rp[d * 32] += o[d][r]; }
        __syncthreads();
    }
}
__device__ __forceinline__ void nsa_b3(ArgP a, LAS unsigned char* lds_g, int item, int tid_in, int lane_in, int wave) {
    NSA_SETUP
    NSA_LOADQ
    f32x16 o[4]; (void)o;
    {
        const bf16* Kg = KV + ((size_t)(4 * 2 + g) * NM + rowbase) * 128;
        const bf16* Vg = KV + ((size_t)(5 * 2 + g) * NM + rowbase) * 128;
#pragma unroll
        for (int d = 0; d < 4; ++d) o[d] = f32x16{};
        float l = 0.f;
        const float CB = ((const LAS float*)(L + A_BIAS))[12 * BT_STRIDE + 3];
        const int j0 = ci >= 8 ? ci - 8 : 0, NTI = ci - j0 + 1;
        const int sr = tid >> 4, sc = (tid & 15) * 8, vst0 = v_st(sr, sc), vst1 = v_st(32 + sr, sc), kws = KSWZ(sr, sc * 2);
        Stage1 S;
        stage_load(S, Kg + (size_t)j0 * 64 * 128, Vg + (size_t)j0 * 64 * 128, sr, sc);
        stage_write(S, L + A_KBUF, L + A_VBUF, kws, vst0, vst1);
        if (NTI > 1) stage_load(S, Kg + (size_t)(j0 + 1) * 64 * 128, Vg + (size_t)(j0 + 1) * 64 * 128, sr, sc);
        for (int n = 0; n < NTI; ++n) {
            const int j = j0 + n;
            __syncthreads();
            LAS char* Kb = L + A_KBUF + (n & 1) * SHM_K; LAS char* Vb = L + A_VBUF + (n & 1) * 2 * SHM_V;
            if (n + 1 < NTI) { stage_write(S, L + A_KBUF + ((n + 1) & 1) * SHM_K, L + A_VBUF + ((n + 1) & 1) * 2 * SHM_V, kws, vst0, vst1);
                if (n + 2 < NTI) stage_load(S, Kg + (size_t)(j + 2) * 64 * 128, Vg + (size_t)(j + 2) * 64 * 128, sr, sc); }
            f32x16 p0, p1;
            qkt(p0, p1, Kb, r32, hi, qr);
            float cbias = cb;
            if (j >= ci - 2) { xform<true>(p0, p1, tq - j * 64 - 4 * hi, 512u, true, cb, tab); cbias = 0.f; }
            else if (j == ci - 8) { xform<false>(p0, p1, tq - j * 64 - 4 * hi, 512u, true, cb, tab); cbias = 0.f; }
            bf16x8 pa0, pa1, pa2, pa3;
            sm_step_c(p0, p1, l, pa0, pa1, pa2, pa3, cbias - CB);
            pv_tile(o, (int)(unsigned)(uintptr_t)Vb + vrb, pa0, pa1, pa2, pa3);
        }
        __syncthreads();
        scale_rows<4>(o, Gt[2] / l, wscr, r32, hi);
        unsigned ob = obase0; asm volatile("" : "+v"(ob));
#pragma unroll
        for (int r = 0; r < 16; ++r) { const size_t ro = OROW(r);
#pragma unroll
            for (int d = 0; d < 4; ++d) { const float v = TMP[ro + d * 32] + o[d][r]; const float vn = __shfl_xor(v, 1);
                if ((r32 & 1) == 0) *(unsigned*)(ONSA + ro + (ro & ~(size_t)1023) + d * 32) = cvtpk(v, vn); } }
        __syncthreads();
    }
}
__device__ __forceinline__ void nsa_item(ArgP a, LAS unsigned char* lds_g, int item, int tid, int lane, int wave) {
    nsa_b1(a, lds_g, item, tid, lane, wave);
    nsa_sel(a, lds_g, item, tid, lane, wave);
    nsa_b2(a, lds_g, item, tid, lane, wave);
    nsa_b3(a, lds_g, item, tid, lane, wave);
}
#undef NSA_SETUP
#undef NSA_LOADQ
#undef IMPP
#undef OROW
__device__ __forceinline__ void diff_finalize(ArgP a, int gw, int NGW, int lane) {
    unsigned char* ws = a->ws;
    const float lam = *(const float*)(ws + WS_SMALL + SM_LAM);
    const float* D0 = (const float*)(ws + WS_DTMP); const float* D1 = D0 + (size_t)NM * 1024;
    bf16* OD = (bf16*)(ws + WS_ONSA) + 1024;
    const f32x4 gn = *(const f32x4*)(a->in[16] + 4 * lane);
    for (int it = gw; it < NM * 4; it += NGW) {
        const size_t off = (size_t)it * 256 + 4 * lane;
        const f32x4 x0 = *(const f32x4*)(D0 + off), x1 = *(const f32x4*)(D1 + off);
        const f32x4 v = x0 - x1 * lam;
        const float ss = wave_sum((v[0] * v[0] + v[1] * v[1]) + (v[2] * v[2] + v[3] * v[3]));
        const float rs = rsqrtf(ss * (1.0f / 256.0f) + EPSF) * (1.0f - LAM_INIT);
        const f32x4 y = v * rs * gn;
        u32x2 w; w.x = pk2(y[0], y[1]); w.y = pk2(y[2], y[3]);
        *(u32x2*)(OD + off + ((size_t)(it >> 2) << 10)) = w;
    }
}

__device__ __forceinline__ void phase4(ArgP a, LAS unsigned char* lds, int tid, int lane, int wave) {
    LAS unsigned char* lds_g = lds;
    build_bias(a, (LAS float*)(lds_g + A_BIAS), tid);
    __syncthreads();
    for (int it = blockIdx.x; it < 256; it += gridDim.x) nsa_item(a, lds_g, (it & 7) * 32 + (it >> 3), tid, lane, wave);
    diff_finalize(a, blockIdx.x * NWAVES + wave, gridDim.x * NWAVES, lane);
    weights_b_queue(a, lds_g, wave, lane);
}
#ifndef ONE_LAUNCH
#define ONE_LAUNCH 0
#endif
constexpr int N_PHASES = 11;
__global__ void __launch_bounds__(NTHR, 2) mk_fwd(Args a) {
    extern __shared__ __attribute__((aligned(16))) unsigned char lds_raw[];
    LAS unsigned char* lds = (LAS unsigned char*)lds_raw;
    const int wave0 = __builtin_amdgcn_readfirstlane(threadIdx.x >> 6);
    const int lo = a.ph_lo, hi = a.ph_hi;
#define MK_TID(t_) int t_; { int w_ = wave0; asm volatile("" : "+s"(w_)); int l_; asm volatile("v_mbcnt_lo_u32_b32 %0, -1, 0\n\tv_mbcnt_hi_u32_b32 %0, -1, %0" : "=v"(l_)); t_ = w_ * 64 + l_; }
#if ONE_LAUNCH
    XcdBarrier bar;
    { MK_TID(t0_) if (t0_ < 16) ((volatile LAS unsigned*)(lds + MISC_OFF))[t0_] = 0u; __syncthreads();
      ArgP ap0 = argp(); bar = xcd_barrier_post((unsigned*)(ap0->ws + WS_SMALL + SM_BAR), (volatile LAS unsigned*)(lds + MISC_OFF), t0_);
    }
#define SEAM(k) do { if (lo <= (k) && (k) + 1 < hi) { MK_TID(ts_) xcd_barrier(bar, ts_); } } while (0)
#else
#define SEAM(k) do { } while (0)
#endif
#define IN(k) (lo <= (k) && (k) < hi)
#define PH_BEGIN ArgP ap = argp(); unsigned char* ws = ap->ws; float* mod = (float*)(ws + WS_SMALL + SM_MOD); (void)mod; \
    int wave = wave0; asm volatile("" : "+s"(wave)); int lane; asm volatile("v_mbcnt_lo_u32_b32 %0, -1, 0\n\tv_mbcnt_hi_u32_b32 %0, -1, %0" : "=v"(lane)); \
    const int tid = wave * 64 + lane, G = gridDim.x, gw = blockIdx.x * NWAVES + wave, NGW = G * NWAVES, gtid = blockIdx.x * NTHR + tid, NGT = G * NTHR; (void)gw; (void)NGW; (void)gtid; (void)NGT; (void)G;

    if (IN(0)) { PH_BEGIN p0_adaln(ap, lds, tid); p0_small(ap, tid); __syncthreads(); p0_weights(ap, lds, gw, NGW, wave, lane); }
    SEAM(0);
    if (IN(1)) { PH_BEGIN norm_rows(ap->in[0], ap->in[4], mod + 0, mod + 2048, (bf16*)(ws + WS_H), gw, NGW, lane); }
    SEAM(1);
    if (IN(2)) { PH_BEGIN
        pg8::Gemm g{(const bf16*)(ws + WS_H), (const bf16*)(ws + WS_WIN), NM, NIN, ND}; pg8::StaticOrder S; S.init(NM, NIN, G, (int)blockIdx.x);
        pg8::EpiInProj E{(bf16*)(ws + WS_QN), (bf16*)(ws + WS_KV), (bf16*)(ws + WS_DQ), (bf16*)(ws + WS_DK), (bf16*)(ws + WS_DV), (bf16*)(ws + WS_MG), (float*)(ws + WS_SMALL + SM_G),
                          ap->in[7], ap->in[8], ap->in[12], ap->in[13], (LAS float*)(lds + XL_OFF), QSCALE, EPSF};
        pg8::gemm_phase<pg8::EpiInProj, pg8::StaticOrder, true, true>(lds, g, S, E, tid, wave, lane);
    }
    SEAM(2);
    if (IN(3)) { PH_BEGIN phase3(ap, lds, tid, lane, wave); }
    SEAM(3);
    if (IN(4)) { PH_BEGIN phase4(ap, lds, tid, lane, wave); }
    SEAM(4);
    if (IN(5)) { PH_BEGIN
        pg8::Gemm g{(const bf16*)(ws + WS_ONSA), (const bf16*)(ws + WS_WNSA), NM, ND, 2048}; pg8::StaticOrder S; S.init(NM, ND, G, (int)blockIdx.x);
        pg8::EpiMix E{(const bf16*)(ws + WS_MG), (bf16*)(ws + WS_MIX)};
        pg8::gemm_phase<pg8::EpiMix, pg8::StaticOrder, true, true>(lds, g, S, E, tid, wave, lane);
    }
    SEAM(5);
    if (IN(6)) { PH_BEGIN
        pg8::Gemm g{(const bf16*)(ws + WS_MIX), (const bf16*)(ws + WS_WO), NM, ND, ND}; pg8::StaticOrder S; S.init(NM, ND, G, (int)blockIdx.x);
        if (G == 256) {
            pg8::EpiResidNorm E{ap->in[0], mod + 4096, 12288, ap->out, (bf16*)(ws + WS_H), ap->in[5], mod + 8192, mod + 6144,
                                (unsigned*)(ws + WS_SMALL + SM_SLOTS), (unsigned*)(ws + WS_SMALL + SM_PCNT), EPSF};
            pg8::gemm_phase<pg8::EpiResidNorm, pg8::StaticOrder, false, true>(lds, g, S, E, tid, wave, lane);
        } else {
            pg8::EpiResid E{ap->in[0], mod + 4096, 12288, ap->out};
            pg8::gemm_phase<pg8::EpiResid, pg8::StaticOrder, true, true>(lds, g, S, E, tid, wave, lane);
        }
    }
    SEAM(6);
    if (IN(7) && gridDim.x != 256) { PH_BEGIN norm_rows(ap->out, ap->in[5], mod + 6144, mod + 8192, (bf16*)(ws + WS_H), gw, NGW, lane); }
    if (gridDim.x != 256) SEAM(7);
    if (IN(8)) { PH_BEGIN
        pg8::Gemm g{(const bf16*)(ws + WS_H), (const bf16*)(ws + WS_WUP), NM, NUP, ND}; pg8::StaticOrder S; S.init(NM, NUP, G, (int)blockIdx.x);
        pg8::EpiUpAct E{(bf16*)(ws + WS_ACT2), ap->in[21], ap->in[22], (float*)(ws + WS_HF), (float*)(ws + WS_HL), (LAS float*)(lds + XL_OFF), NF, NUP};
        pg8::gemm_phase<pg8::EpiUpAct, pg8::StaticOrder, true, true>(lds, g, S, E, tid, wave, lane);
    }
    SEAM(8);
    if (IN(10)) { PH_BEGIN
        pg8::Gemm g{(const bf16*)(ws + WS_ACT2), (const bf16*)(ws + WS_WDOWN), NM, ND, NF}; pg8::StaticOrder S; S.init(NM, ND, G, (int)blockIdx.x);
        { pg8::Unit u0; for (int i = 0; S.next(i, u0); ++i) act_fixup((const float*)(ws + WS_HF), (const float*)(ws + WS_HL), ap->in[21], ap->in[22], (bf16*)(ws + WS_ACT2), u0.pm, tid);
          asm volatile("s_waitcnt vmcnt(0)" ::: "memory"); __syncthreads(); }
        pg8::EpiResid E{ap->out, mod + 10240, 12288, ap->out};
        pg8::gemm_phase<pg8::EpiResid, pg8::StaticOrder, true, true>(lds, g, S, E, tid, wave, lane);
    }
#undef IN
#undef PH_BEGIN
#undef SEAM
}

extern "C" void kernel_launch(void* const* d_in, const int* in_sizes, int n_in, void* d_out, int out_size, void* d_ws, size_t ws_size, hipStream_t stream) {
    static int grid = 0;
    if (grid == 0) {
        if (n_in != 25 || out_size != NM * ND || ws_size < WS_END) { fprintf(stderr, "kernel_launch: unexpected shapes (n_in %d out %d ws %zu)\n", n_in, out_size, ws_size); grid = -1; return; }
        int dev = 0, cus = 0, per_cu = 0;
        (void)hipGetDevice(&dev); (void)hipDeviceGetAttribute(&cus, hipDeviceAttributeMultiprocessorCount, dev);
        if (hipFuncSetAttribute((const void*)mk_fwd, hipFuncAttributeMaxDynamicSharedMemorySize, LDS_BYTES) != hipSuccess) { fprintf(stderr, "kernel_launch: hipFuncSetAttribute failed\n"); grid = -1; return; }
        if (hipOccupancyMaxActiveBlocksPerMultiprocessor(&per_cu, (const void*)mk_fwd, NTHR, LDS_BYTES) != hipSuccess || per_cu < 1) { fprintf(stderr, "kernel_launch: occupancy query says %d\n", per_cu); per_cu = 1; }
        (void)hipGetLastError();
        grid = cus < 256 ? cus : 256;
    }
    if (grid < 0) return;
    Args a{};
    for (int i = 0; i < 25; ++i) a.in[i] = (const float*)d_in[i];
    a.out = (float*)d_out; a.ws = (unsigned char*)d_ws;
    (void)hipMemsetAsync((char*)d_ws + WS_SMALL + SM_BAR, 0, SM_BAR_BYTES, stream);
#if ONE_LAUNCH
    a.ph_lo = 0; a.ph_hi = N_PHASES;
    void* args[] = {&a};
    hipError_t e = hipLaunchCooperativeKernel((const void*)mk_fwd, dim3(grid), dim3(NTHR), args, LDS_BYTES, stream);
    if (e != hipSuccess) fprintf(stderr, "cooperative launch failed: %s (grid %d)\n", hipGetErrorString(e), grid);
#else
    for (int p = 0; p < N_PHASES; ++p) {
        if (p == 9) continue;
        a.ph_lo = p; a.ph_hi = p + 1;
        hipLaunchKernelGGL(mk_fwd, dim3(grid), dim3(NTHR), LDS_BYTES, stream, a);
    }
#endif
}
```

```cpp
#include <hip/hip_runtime.h>
#include <hip/hip_cooperative_groups.h>
#include <cstdio>
#include <cstdint>
namespace cg = cooperative_groups;
#define ONE_LAUNCH 1
namespace pg8 {
#define PG8_LAS __attribute__((address_space(3)))
typedef unsigned short bf16_t;
typedef short bf16x8 __attribute__((ext_vector_type(8)));
typedef float f32x4 __attribute__((ext_vector_type(4)));
typedef unsigned u32x4 __attribute__((ext_vector_type(4)));
constexpr int BM = 256, BK = 64, HALF = 128, HTB = HALF * BK * 2  , STAGE_BYTES = 8 * HTB, NXCD = 8, WGM = 8;

__host__ __device__ __forceinline__ int lds_byte(int r, int c) { const int st = (r >> 4) * 2 + (c >> 5), rr = r & 15, cc = c & 31, ob = rr * 64 + cc * 2; return st * 1024 + (ob ^ (((ob >> 9) & 1) << 5)); }
__host__ __device__ __forceinline__ void stage_rc(int b, int& R, int& C) { const int st = b / 1024, sb = b % 1024, swz = sb ^ (((sb >> 9) & 1) << 5); R = (st >> 1) * 16 + swz / 64; C = (st & 1) * 32 + (swz % 64) / 2; }
__host__ __device__ __forceinline__ int perm32(int rho) { const int n = rho >> 4, i = rho & 15; return 8 * (i >> 2) + 4 * n + (i & 3); }

struct Unit { int pm, pn; };
struct Gemm { const bf16_t* A; const bf16_t* Bt; int M, N, K; };

struct StaticOrder {
    int nM, nN, nwg, G, c;
    __host__ __device__ void init(int M, int N, int G_, int c_) { nM = M / BM; nN = N / BM; nwg = nM * nN; G = G_; c = c_; }
    __host__ __device__ bool next(int i, Unit& u) const {
        const long L = (long)i * G + c; if (L >= nwg) return false;
        int wgid = (int)L; { const int q = nwg / NXCD, r = nwg % NXCD, xcd = wgid % NXCD, off = wgid / NXCD; wgid = (xcd < r ? xcd * (q + 1) : r * (q + 1) + (xcd - r) * q) + off; }
        const int nig = WGM * nN, gid = wgid / nig, fm = gid * WGM, gsz = (nM - fm) < WGM ? (nM - fm) : WGM;
        u.pm = fm + ((wgid % nig) % gsz); u.pn = (wgid % nig) / gsz; return true;
    }
    __device__ __forceinline__ void a_ready(const Unit&) const {}
    __device__ __forceinline__ void done(const Unit&) const {}
};
__device__ __forceinline__ unsigned cvt_pk_bf16(float lo, float hi) { unsigned r; asm volatile("v_cvt_pk_bf16_f32 %0, %1, %2" : "=v"(r) : "v"(lo), "v"(hi)); return r; }
typedef unsigned u32x4 __attribute__((ext_vector_type(4)));
__device__ __forceinline__ void st8_bf16(bf16_t* p, f32x4 v0, f32x4 v1) {
    u32x4 w; w.x = cvt_pk_bf16(v0[0], v0[1]); w.y = cvt_pk_bf16(v0[2], v0[3]); w.z = cvt_pk_bf16(v1[0], v1[1]); w.w = cvt_pk_bf16(v1[2], v1[3]);
    *(u32x4*)p = w;
}
__device__ __forceinline__ void ld8_bf16(const bf16_t* p, f32x4& v0, f32x4& v1) {
    const u32x4 w = *(const u32x4*)p;
    v0[0] = __uint_as_float(w.x << 16); v0[1] = __uint_as_float(w.x & 0xffff0000u); v0[2] = __uint_as_float(w.y << 16); v0[3] = __uint_as_float(w.y & 0xffff0000u);
    v1[0] = __uint_as_float(w.z << 16); v1[1] = __uint_as_float(w.z & 0xffff0000u); v1[2] = __uint_as_float(w.w << 16); v1[3] = __uint_as_float(w.w & 0xffff0000u);
}
__device__ __forceinline__ float sigmoidf_(float x) { return 1.0f / (1.0f + __expf(-x)); }

struct EpiInProj {
    static constexpr bool PERM = true, AFTER_DRAIN = false, HAS_MID = false;
    bf16_t *QN, *KV, *DQ, *DK, *DV, *MG; float* G;
    const float *qgain, *kgain, *dqgain, *dkgain;
    PG8_LAS float* xl;
    float qscale, eps;
    __device__ __forceinline__ void operator()(const f32x4 (&acc)[2][2][4][2], const Unit& u, int wr, int wc, int fr, int fq) const {
        const int pn = u.pn, row0 = u.pm * BM + wr * 64 + fr, cw = wc * 32 + 8 * fq;
        int mode; bf16_t* dst; int ldc, cbase, bjs; const float* gain = nullptr; float sc = 1.f;
        constexpr int SL = 8192 * 128;
        if (pn < 4)        { mode = 0; dst = QN + (size_t)(pn * 2) * SL; ldc = 128; cbase = 0; bjs = SL; gain = qgain; sc = qscale; }
        else if (pn < 10)  { const int br = (pn - 4) >> 1, kvsel = (pn - 4) & 1; dst = KV + (size_t)((pn - 4) * 2) * SL; ldc = 128; cbase = 0; bjs = SL;
                             if (kvsel == 0 && br > 0) { mode = 0; gain = kgain + br * 128; } else mode = 1; }
        else if (pn < 14)  { mode = 0; dst = DQ + (size_t)((pn - 10) * 2) * SL; ldc = 128; cbase = 0; bjs = SL; gain = dqgain; sc = qscale; }
        else if (pn < 18)  { mode = 0; dst = DK + (size_t)((pn - 14) * 2) * SL; ldc = 128; cbase = 0; bjs = SL; gain = dkgain; }
        else if (pn < 22)  { mode = 1; dst = DV + (size_t)(pn - 18) * (2 * SL); ldc = 256; cbase = 0; bjs = HALF; }
        else if (pn < 38)  { mode = 2; dst = MG; ldc = 4096; cbase = (pn - 22) * 256; bjs = HALF; }
        else               { mode = 3; dst = nullptr; ldc = 0; cbase = 0; bjs = 0; }
        if (mode == 0) {
#pragma unroll
            for (int ai = 0; ai < 2; ++ai)
#pragma unroll
                for (int m = 0; m < 4; ++m)
#pragma unroll
                    for (int bj = 0; bj < 2; ++bj) {
                        const f32x4 a = acc[ai][bj][m][0], b = acc[ai][bj][m][1];
                        float s = (a[0] * a[0] + a[1] * a[1]) + (a[2] * a[2] + a[3] * a[3]) + (b[0] * b[0] + b[1] * b[1]) + (b[2] * b[2] + b[3] * b[3]);
                        s += __shfl_xor(s, 16); s += __shfl_xor(s, 32);
                        if (fq == 0) xl[(ai * HALF + wr * 64 + m * 16 + fr) * 8 + bj * 4 + wc] = s;
                    }
            asm volatile("s_waitcnt lgkmcnt(0)" ::: "memory"); __builtin_amdgcn_s_barrier(); asm volatile("" ::: "memory");
            f32x4 g0 = *(const f32x4*)(gain + cw), g1 = *(const f32x4*)(gain + cw + 4);
            g0 = g0 * sc; g1 = g1 * sc;
#pragma unroll
            for (int ai = 0; ai < 2; ++ai)
#pragma unroll
                for (int m = 0; m < 4; ++m) { const int rl = ai * HALF + wr * 64 + m * 16 + fr; bf16_t* rowp = dst + (size_t)(u.pm * BM + rl) * ldc + cbase + cw;
#pragma unroll
                    for (int bj = 0; bj < 2; ++bj) {
                        const f32x4 ps = *(const PG8_LAS f32x4*)(xl + rl * 8 + bj * 4);
                        const float rs = rsqrtf(((ps[0] + ps[1]) + (ps[2] + ps[3])) * (1.0f / 128.0f) + eps);
                        st8_bf16(rowp + (size_t)bj * bjs, acc[ai][bj][m][0] * rs * g0, acc[ai][bj][m][1] * rs * g1); } }
        } else if (mode == 1) {
#pragma unroll
            for (int ai = 0; ai < 2; ++ai)
#pragma unroll
                for (int m = 0; m < 4; ++m) { bf16_t* rowp = dst + (size_t)(row0 + ai * HALF + m * 16) * ldc + cbase + cw;
#pragma unroll
                    for (int bj = 0; bj < 2; ++bj) st8_bf16(rowp + (size_t)bj * bjs, acc[ai][bj][m][0], acc[ai][bj][m][1]); }
        } else if (mode == 2) {
#pragma unroll
            for (int ai = 0; ai < 2; ++ai)
#pragma unroll
                for (int m = 0; m < 4; ++m) { bf16_t* rowp = dst + (size_t)(row0 + ai * HALF + m * 16) * ldc + cbase + cw;
#pragma unroll
                    for (int bj = 0; bj < 2; ++bj) { f32x4 a = acc[ai][bj][m][0], b = acc[ai][bj][m][1];
#pragma unroll
                        for (int e = 0; e < 4; ++e) { a[e] = sigmoidf_(a[e]); b[e] = sigmoidf_(b[e]); }
                        st8_bf16(rowp + (size_t)bj * bjs, a, b); } }
        } else {
            if (wc == 0 && fq < 3) {
#pragma unroll
                for (int ai = 0; ai < 2; ++ai)
#pragma unroll
                    for (int m = 0; m < 4; ++m) { float* gp = G + (size_t)(row0 + ai * HALF + m * 16) * 24 + 8 * fq;
                        f32x4 a = acc[ai][0][m][0], b = acc[ai][0][m][1];
#pragma unroll
                        for (int e = 0; e < 4; ++e) { a[e] = sigmoidf_(a[e]); b[e] = sigmoidf_(b[e]); }
                        *(f32x4*)gp = a; *(f32x4*)(gp + 4) = b; }
            }
        }
    }
};

struct EpiMix {
    static constexpr bool PERM = true, AFTER_DRAIN = false, HAS_MID = true;
    const bf16_t* MG; bf16_t* MIX;
    __device__ __forceinline__ void mid(f32x4 (&acc)[2][2][4][2], const Unit& u, int wr, int wc, int fr, int fq) const {
        int c0 = wc * 32 + 8 * fq, row0 = u.pm * BM + wr * 64 + fr; asm volatile("" : "+v"(c0), "+v"(row0));
        const int col0 = u.pn * BM + c0;
#pragma unroll
        for (int ai = 0; ai < 2; ++ai)
#pragma unroll
            for (int m = 0; m < 4; ++m) { const size_t row = (size_t)(row0 + ai * HALF + m * 16);
#pragma unroll
                for (int bj = 0; bj < 2; ++bj) { f32x4 g0, g1, h0, h1; ld8_bf16(MG + row * 4096 + col0 + bj * HALF, g0, g1); ld8_bf16(MG + row * 4096 + 2048 + col0 + bj * HALF, h0, h1);
#pragma unroll
                    for (int e = 0; e < 4; ++e) { acc[ai][bj][m][0][e] *= g0[e] * __builtin_amdgcn_rcpf(fmaxf(h0[e], 1e-30f)); acc[ai][bj][m][1][e] *= g1[e] * __builtin_amdgcn_rcpf(fmaxf(h1[e], 1e-30f)); }
                    __builtin_amdgcn_sched_barrier(0); } }
    }
    __device__ __forceinline__ void operator()(const f32x4 (&acc)[2][2][4][2], const Unit& u, int wr, int wc, int fr, int fq) const {
        int row0 = u.pm * BM + wr * 64 + fr, col0 = u.pn * BM + wc * 32 + 8 * fq; asm volatile("" : "+v"(row0), "+v"(col0));
#pragma unroll
        for (int ai = 0; ai < 2; ++ai)
#pragma unroll
            for (int m = 0; m < 4; ++m) { const size_t row = (size_t)(row0 + ai * HALF + m * 16);
#pragma unroll
                for (int bj = 0; bj < 2; ++bj) { f32x4 h0, h1; ld8_bf16(MG + row * 4096 + 2048 + col0 + bj * HALF, h0, h1);
                    st8_bf16(MIX + row * 2048 + col0 + bj * HALF, h0 * acc[ai][bj][m][0], h1 * acc[ai][bj][m][1]); } }
    }
};
struct EpiResid {
    static constexpr bool PERM = true, AFTER_DRAIN = false, HAS_MID = false;
    const float* base; const float* gate; int gstride; float* out;
    __device__ __forceinline__ void operator()(const f32x4 (&acc)[2][2][4][2], const Unit& u, int wr, int wc, int fr, int fq) const {
        const int row0 = u.pm * BM + wr * 64 + fr, col0 = u.pn * BM + wc * 32 + 8 * fq;
        const float* gp = gate + (size_t)(u.pm >> 3) * gstride + col0;
        f32x4 gv[2][2];
#pragma unroll
        for (int bj = 0; bj < 2; ++bj) { gv[bj][0] = *(const f32x4*)(gp + bj * HALF); gv[bj][1] = *(const f32x4*)(gp + bj * HALF + 4); }
#pragma unroll
        for (int ai = 0; ai < 2; ++ai)
#pragma unroll
            for (int m = 0; m < 4; ++m) { const size_t off = (size_t)(row0 + ai * HALF + m * 16) * 2048 + col0;
#pragma unroll
                for (int bj = 0; bj < 2; ++bj) {
                    const f32x4 x0 = *(const f32x4*)(base + off + bj * HALF), x1 = *(const f32x4*)(base + off + bj * HALF + 4);
                    *(f32x4*)(out + off + bj * HALF) = x0 + gv[bj][0] * acc[ai][bj][m][0];
                    *(f32x4*)(out + off + bj * HALF + 4) = x1 + gv[bj][1] * acc[ai][bj][m][1]; } }
    }
};

__device__ __forceinline__ float dpp_ror(float v, const int n) { return n == 1 ? __int_as_float(__builtin_amdgcn_update_dpp(0, __float_as_int(v), 0x121, 0xf, 0xf, false)) : __int_as_float(__builtin_amdgcn_update_dpp(0, __float_as_int(v), 0x122, 0xf, 0xf, false)); }
__device__ __forceinline__ float silu_fast(float x) { return x * __builtin_amdgcn_rcpf(1.0f + __builtin_amdgcn_exp2f(-1.4426950408889634f * x)); }
struct EpiUpAct {
    static constexpr bool PERM = true, AFTER_DRAIN = false, HAS_MID = false;
    bf16_t* ACT; const float* cw; const float* cb; float* HF; float* HL; PG8_LAS float* xb; int NFc, NUPc;
    __device__ __forceinline__ void operator()(const f32x4 (&acc)[2][2][4][2], const Unit& u, int wr, int wc, int fr, int fq) const {
        int cl = wc * 32 + 8 * fq; asm volatile("" : "+v"(cl));
        const int colt = u.pn * BM;
#pragma unroll
        for (int ai = 0; ai < 2; ++ai)
#pragma unroll
            for (int bj = 0; bj < 2; ++bj)
                if (fr >= 14) { PG8_LAS float* p = xb + ((ai * 2 + wr) * 2 + (fr - 14)) * 256 + bj * HALF + cl; *(PG8_LAS f32x4*)p = acc[ai][bj][3][0]; *(PG8_LAS f32x4*)(p + 4) = acc[ai][bj][3][1]; }
        if (wr == 0 && fr < 2) {
#pragma unroll
            for (int bj = 0; bj < 2; ++bj) { float* p = HF + (size_t)(u.pm * 2 + fr) * NUPc + colt + bj * HALF + cl; *(f32x4*)p = acc[0][bj][0][0]; *(f32x4*)(p + 4) = acc[0][bj][0][1]; } }
        if (wr == 1 && fr >= 14) {
#pragma unroll
            for (int bj = 0; bj < 2; ++bj) { float* p = HL + (size_t)(u.pm * 2 + fr - 14) * NUPc + colt + bj * HALF + cl; *(f32x4*)p = acc[1][bj][3][0]; *(f32x4*)(p + 4) = acc[1][bj][3][1]; } }
        asm volatile("s_waitcnt lgkmcnt(0)" ::: "memory"); __builtin_amdgcn_s_barrier(); asm volatile("" ::: "memory");
        const bool bstart = (u.pm & 7) == 0;
#pragma unroll
        for (int ai = 0; ai < 2; ++ai) {
            const int band = ai * 2 + wr;
            unsigned pk0[4][2];
#pragma unroll
            for (int n = 0; n < 2; ++n) {
                f32x4 cva[4];
#pragma unroll
                for (int bj = 0; bj < 2; ++bj) {
                    const int ch = (bj ? NFc : 0) + u.pn * HALF + cl + 4 * n;
                    const f32x4 w0 = *(const f32x4*)(cw + ch), w1 = *(const f32x4*)(cw + NUPc + ch), w2 = *(const f32x4*)(cw + 2 * NUPc + ch), bb = *(const f32x4*)(cb + ch);
                    f32x4 B0 = {0.f, 0.f, 0.f, 0.f}, B1 = B0;
                    if (band > 0) { const PG8_LAS float* p = xb + ((band - 1) * 2) * 256 + bj * HALF + cl + 4 * n; B0 = *(const PG8_LAS f32x4*)p; B1 = *(const PG8_LAS f32x4*)(p + 256); }
                    f32x4 P1 = B1, P2;
#pragma unroll
                    for (int e = 0; e < 4; ++e) P2[e] = fr == 0 ? B0[e] : B1[e];
#pragma unroll
                    for (int m = 0; m < 4; ++m) {
                        const f32x4 X = acc[ai][bj][m][n]; f32x4 R1, R2, c;
#pragma unroll
                        for (int e = 0; e < 4; ++e) { R1[e] = dpp_ror(X[e], 1); R2[e] = dpp_ror(X[e], 2);
                            const float u1 = fr == 0 ? P1[e] : R1[e], u2 = fr < 2 ? P2[e] : R2[e];
                            c[e] = bb[e] + w0[e] * u2 + w1[e] * u1 + w2[e] * X[e]; }
                        P1 = R1; P2 = R2;
                        if (bj == 0) cva[m] = c;
                        else {
                            f32x4 a;
#pragma unroll
                            for (int e = 0; e < 4; ++e) a[e] = silu_fast(cva[m][e]) * c[e];
                            if (n == 0) { pk0[m][0] = cvt_pk_bf16(a[0], a[1]); pk0[m][1] = cvt_pk_bf16(a[2], a[3]); }
                            else { u32x4 w; w.x = pk0[m][0]; w.y = pk0[m][1]; w.z = cvt_pk_bf16(a[0], a[1]); w.w = cvt_pk_bf16(a[2], a[3]);
                                const bool skip = band == 0 && m == 0 && fr < 2 && !bstart;
                                if (!skip) *(u32x4*)(ACT + (size_t)(u.pm * BM + ai * HALF + wr * 64 + m * 16 + fr) * NFc + u.pn * HALF + cl) = w; }
                        }
                    }
                    __builtin_amdgcn_sched_barrier(0);
                }
            }
        }
    }
};

struct EpiResidNorm {
    static constexpr bool PERM = true, AFTER_DRAIN = true, HAS_MID = false;
    const float* base; const float* gate; int gstride; float* out;
    bf16_t* H; const float* gain; const float* sc; const float* sh;
    unsigned* slots; unsigned* cnt; float eps;
    __device__ __forceinline__ void operator()(const f32x4 (&)[2][2][4][2], const Unit&, int, int, int, int) const {}
    __device__ __forceinline__ void fused(f32x4 (&acc)[2][2][4][2], const Unit& u, int wr, int wc, int fr, int fq, PG8_LAS unsigned char* lds, int wid, int lane) const {
        PG8_LAS float* P = (PG8_LAS float*)lds;
        PG8_LAS float* S = (PG8_LAS float*)(lds + 4096);
        const int row0 = u.pm * BM + wr * 64 + fr, col0 = u.pn * BM + wc * 32 + 8 * fq, bidx = u.pm >> 3;
        { const float* gp = gate + (size_t)bidx * gstride + col0;
          f32x4 gv[2][2];
#pragma unroll
          for (int bj = 0; bj < 2; ++bj) { gv[bj][0] = *(const f32x4*)(gp + bj * HALF); gv[bj][1] = *(const f32x4*)(gp + bj * HALF + 4); }
#pragma unroll
          for (int ai = 0; ai < 2; ++ai)
#pragma unroll
            for (int m = 0; m < 4; ++m) { const size_t off = (size_t)(row0 + ai * HALF + m * 16) * 2048 + col0; float s = 0.f;
#pragma unroll
                for (int bj = 0; bj < 2; ++bj) {
                    const f32x4 x0 = *(const f32x4*)(base + off + bj * HALF), x1 = *(const f32x4*)(base + off + bj * HALF + 4);
                    const f32x4 v0 = x0 + gv[bj][0] * acc[ai][bj][m][0], v1 = x1 + gv[bj][1] * acc[ai][bj][m][1];
                    *(f32x4*)(out + off + bj * HALF) = v0; *(f32x4*)(out + off + bj * HALF + 4) = v1;
                    acc[ai][bj][m][0] = v0; acc[ai][bj][m][1] = v1; asm volatile("" : "+v"(acc[ai][bj][m][0]), "+v"(acc[ai][bj][m][1]));
                    s += (v0[0] * v0[0] + v0[1] * v0[1]) + (v0[2] * v0[2] + v0[3] * v0[3]) + (v1[0] * v1[0] + v1[1] * v1[1]) + (v1[2] * v1[2] + v1[3] * v1[3]); }
                s += __shfl_xor(s, 16); s += __shfl_xor(s, 32);
                if (fq == 0) P[(ai * HALF + wr * 64 + m * 16 + fr) * 4 + wc] = s; } }
        asm volatile("s_waitcnt lgkmcnt(0)" ::: "memory"); __builtin_amdgcn_s_barrier(); asm volatile("" ::: "memory");
        const int prow = wid * 32 + (lane & 31);
        if (lane < 32) { const f32x4 p = *(const PG8_LAS f32x4*)(P + prow * 4);
            __hip_atomic_store(slots + (size_t)(u.pm * BM + prow) * 8 + u.pn, __float_as_uint((p[0] + p[1]) + (p[2] + p[3])), __ATOMIC_RELAXED, __HIP_MEMORY_SCOPE_AGENT); }
        asm volatile("s_waitcnt vmcnt(0)" ::: "memory");
        if (lane == 0) __hip_atomic_fetch_add(cnt + 64 * u.pm, 1u, __ATOMIC_RELAXED, __HIP_MEMORY_SCOPE_AGENT);
        if (wid == 0) { unsigned spins = 0;
            while ((unsigned)__builtin_amdgcn_readfirstlane((int)__hip_atomic_load(cnt + 64 * u.pm, __ATOMIC_RELAXED, __HIP_MEMORY_SCOPE_AGENT)) < 64u && ++spins < (1u << 22)) __builtin_amdgcn_s_sleep(2);
            __builtin_amdgcn_fence(__ATOMIC_ACQUIRE, "agent"); }
        asm volatile("s_waitcnt vmcnt(0) lgkmcnt(0)" ::: "memory"); __builtin_amdgcn_s_barrier(); asm volatile("" ::: "memory");
        if (lane < 32) { const unsigned* sp = slots + (size_t)(u.pm * BM + prow) * 8; float t = 0.f;
#pragma unroll
            for (int k = 0; k < 8; ++k) t += __uint_as_float(__hip_atomic_load(sp + k, __ATOMIC_RELAXED, __HIP_MEMORY_SCOPE_AGENT));
            S[prow] = rsqrtf(t * (1.0f / 2048.0f) + eps); }
        asm volatile("s_waitcnt lgkmcnt(0)" ::: "memory"); __builtin_amdgcn_s_barrier(); asm volatile("" ::: "memory");
#pragma unroll
        for (int bj = 0; bj < 2; ++bj) {
            const int c = col0 + bj * HALF;
            f32x4 g0 = *(const f32x4*)(gain + c), g1 = *(const f32x4*)(gain + c + 4);
            const f32x4 a0 = *(const f32x4*)(sc + (size_t)bidx * gstride + c), a1 = *(const f32x4*)(sc + (size_t)bidx * gstride + c + 4);
            const f32x4 h0 = *(const f32x4*)(sh + (size_t)bidx * gstride + c), h1 = *(const f32x4*)(sh + (size_t)bidx * gstride + c + 4);
            g0 = g0 * (a0 + 1.0f); g1 = g1 * (a1 + 1.0f);
#pragma unroll
            for (int ai = 0; ai < 2; ++ai)
#pragma unroll
                for (int m = 0; m < 4; ++m) { const int rl = ai * HALF + wr * 64 + m * 16 + fr; const float rs = S[rl];
                    st8_bf16(H + (size_t)(u.pm * BM + rl) * 2048 + c, acc[ai][bj][m][0] * rs * g0 + h0, acc[ai][bj][m][1] * rs * g1 + h1); }
        }
    }
};

template <class Epi, class Sched, bool ALIGN_EPI = false, bool SP2 = false>
__device__ __forceinline__ void gemm_phase(PG8_LAS unsigned char* lds, const Gemm g, const Sched& S, const Epi& E, const int tid, const int wid, const int lane) {
    const int wr = wid >> 2, wc = wid & 3, fr = lane & 15, fq = lane >> 4;
    const int K = g.K, nt = K / BK;
    unsigned voffA[2], voffB[2];
#pragma unroll
    for (int i = 0; i < 2; ++i) { int R, C; stage_rc(tid * 16 + i * 8192, R, C); const int Rb = Epi::PERM ? ((R & ~31) + perm32(R & 31)) : R;
        voffA[i] = (unsigned)(R * K + C) * 2u; voffB[i] = (unsigned)(Rb * K + C) * 2u; }
    const size_t kstep = (size_t)(BK * 2);
    const size_t hstep = (size_t)HALF * K * 2;
    const size_t tstep = 2 * hstep;
    const unsigned ldsw = (unsigned)wid * 1024u;
    const int aoff = lds_byte(wr * 64 + fr, fq * 8), boff = lds_byte(wc * 32 + fr, fq * 8);
#define PG8_SA(b, h) (((b) * 2 + (h)) * HTB)
#define PG8_SB(b, h) ((4 + (b) * 2 + (h)) * HTB)
#define PG8_STAGE(bufoff, gbase, voff) do { _Pragma("unroll") for (int _i = 0; _i < 2; ++_i) \
        __builtin_amdgcn_global_load_lds((const unsigned*)((const char*)(gbase) + (voff)[_i]), (PG8_LAS unsigned*)(lds + (bufoff) + ldsw + _i * 8192), 16, 0, 0); } while (0)
#define PG8_LDA(dst, b, h) do { _Pragma("unroll") for (int m = 0; m < 4; ++m) _Pragma("unroll") for (int k = 0; k < 2; ++k) dst[m][k] = *(const PG8_LAS bf16x8*)(lds + PG8_SA(b, h) + aoff + m * 2048 + k * 1024); } while (0)
#define PG8_LDB(dst, b, h) do { _Pragma("unroll") for (int n = 0; n < 2; ++n) _Pragma("unroll") for (int k = 0; k < 2; ++k) dst[n][k] = *(const PG8_LAS bf16x8*)(lds + PG8_SB(b, h) + boff + n * 2048 + k * 1024); } while (0)
#define PG8_MMA(ai, bj, At, Bt) do { __builtin_amdgcn_s_setprio(1); _Pragma("unroll") for (int m = 0; m < 4; ++m) _Pragma("unroll") for (int n = 0; n < 2; ++n) _Pragma("unroll") for (int k = 0; k < 2; ++k) \
        acc[ai][bj][m][n] = __builtin_amdgcn_mfma_f32_16x16x32_bf16(Bt[n][k], At[m][k], acc[ai][bj][m][n], 0, 0, 0); __builtin_amdgcn_s_setprio(0); } while (0)
#define PG8_WAIT_V(n) asm volatile("s_waitcnt vmcnt(" #n ")" ::: "memory")
#define PG8_WAIT_L(n) asm volatile("s_waitcnt lgkmcnt(" #n ")" ::: "memory")
#define PG8_BAR __builtin_amdgcn_s_barrier()
#define PG8_SCHED __builtin_amdgcn_sched_barrier(0)
    Unit cur, nxt; int ui = 0;
    if (!S.next(0, cur)) return;
    f32x4 acc[2][2][4][2];
#pragma unroll
    for (int a = 0; a < 2; ++a)
#pragma unroll
        for (int b = 0; b < 2; ++b)
#pragma unroll
            for (int m = 0; m < 4; ++m)
#pragma unroll
                for (int n = 0; n < 2; ++n) acc[a][b][m][n] = (f32x4){0.f, 0.f, 0.f, 0.f};
    bf16x8 At[4][2], B0[2][2], B1[2][2];
    const char* cA = (const char*)g.A + (size_t)cur.pm * tstep; const char* cB = (const char*)g.Bt + (size_t)cur.pn * tstep;
    S.a_ready(cur);
    if constexpr (SP2) {
        PG8_STAGE(PG8_SB(0, 0), cB, voffB); PG8_STAGE(PG8_SB(0, 1), cB + hstep, voffB); PG8_STAGE(PG8_SA(0, 0), cA, voffA); PG8_STAGE(PG8_SA(0, 1), cA + hstep, voffA);
        if (wr == 1) PG8_BAR;
        PG8_WAIT_V(2); PG8_BAR;
        PG8_STAGE(PG8_SB(1, 0), cB + kstep, voffB); PG8_STAGE(PG8_SA(1, 0), cA + kstep, voffA); PG8_STAGE(PG8_SB(1, 1), cB + hstep + kstep, voffB);
        PG8_WAIT_V(6); PG8_BAR;
    } else {
        PG8_STAGE(PG8_SB(0, 0), cB, voffB); PG8_STAGE(PG8_SA(0, 0), cA, voffA); PG8_STAGE(PG8_SB(0, 1), cB + hstep, voffB); PG8_STAGE(PG8_SA(0, 1), cA + hstep, voffA);
        if (wr == 1) PG8_BAR;
        PG8_WAIT_V(4); PG8_BAR;
        PG8_STAGE(PG8_SB(1, 0), cB + kstep, voffB); PG8_STAGE(PG8_SA(1, 0), cA + kstep, voffA); PG8_STAGE(PG8_SB(1, 1), cB + hstep + kstep, voffB);
        PG8_WAIT_V(6); PG8_BAR;
    }
    for (;;) {
        const bool has_next = S.next(ui + 1, nxt);
        const char* nA = has_next ? (const char*)g.A + (size_t)nxt.pm * tstep : cA; const char* nB = has_next ? (const char*)g.Bt + (size_t)nxt.pn * tstep : cB;
        for (int t = 0; t < nt; t += 2) {
            if constexpr (Epi::HAS_MID) { if (t == nt / 2) E.mid(acc, cur, wr, wc, fr, fq); }
            const bool last = (t == nt - 2);
            const char* a1 = cA + (size_t)(t + 1) * kstep;
            const char* a2 = last ? nA : cA + (size_t)(t + 2) * kstep; const char* b2 = last ? nB : cB + (size_t)(t + 2) * kstep;
            const char* a3 = a2 + kstep; const char* b3 = b2 + kstep;
            if (last && has_next) S.a_ready(nxt);
            if constexpr (SP2) {
            PG8_LDB(B0, 0, 0); PG8_LDB(B1, 0, 1); PG8_SCHED; PG8_LDA(At, 0, 0); PG8_STAGE(PG8_SA(1, 1), a1 + hstep, voffA);
            PG8_WAIT_V(8); PG8_WAIT_L(0); PG8_BAR; PG8_MMA(0, 0, At, B0); PG8_MMA(0, 1, At, B1); PG8_BAR; PG8_SCHED;
            PG8_LDA(At, 0, 1); PG8_STAGE(PG8_SB(0, 0), b2, voffB); PG8_STAGE(PG8_SB(0, 1), b2 + hstep, voffB); PG8_STAGE(PG8_SA(0, 0), a2, voffA);
            PG8_WAIT_V(8); PG8_WAIT_L(0); PG8_BAR; PG8_MMA(1, 0, At, B0); PG8_MMA(1, 1, At, B1); PG8_BAR; PG8_SCHED;
            PG8_LDB(B0, 1, 0); PG8_LDB(B1, 1, 1); PG8_SCHED; PG8_LDA(At, 1, 0); PG8_STAGE(PG8_SA(0, 1), a2 + hstep, voffA);
            PG8_WAIT_V(8); PG8_WAIT_L(0); PG8_BAR; PG8_MMA(0, 0, At, B0); PG8_MMA(0, 1, At, B1); PG8_BAR; PG8_SCHED;
            PG8_LDA(At, 1, 1); PG8_STAGE(PG8_SB(1, 0), b3, voffB); PG8_STAGE(PG8_SB(1, 1), b3 + hstep, voffB); PG8_STAGE(PG8_SA(1, 0), a3, voffA);
            PG8_WAIT_V(8); PG8_WAIT_L(0); PG8_BAR; PG8_MMA(1, 0, At, B0); PG8_MMA(1, 1, At, B1); PG8_BAR; PG8_SCHED;
            } else {
            PG8_LDB(B0, 0, 0); PG8_SCHED; PG8_LDA(At, 0, 0); PG8_STAGE(PG8_SA(1, 1), a1 + hstep, voffA);
            PG8_WAIT_L(8); PG8_BAR; PG8_WAIT_L(0); PG8_MMA(0, 0, At, B0); PG8_BAR; PG8_SCHED;
            PG8_LDB(B1, 0, 1); PG8_STAGE(PG8_SB(0, 0), b2, voffB);
            PG8_BAR; PG8_WAIT_L(0); PG8_MMA(0, 1, At, B1); PG8_BAR;
            PG8_LDA(At, 0, 1); PG8_STAGE(PG8_SA(0, 0), a2, voffA);
            PG8_BAR; PG8_WAIT_L(0); PG8_MMA(1, 0, At, B0); PG8_BAR; PG8_SCHED;
            PG8_STAGE(PG8_SB(0, 1), b2 + hstep, voffB);
            PG8_WAIT_V(6); PG8_BAR; PG8_MMA(1, 1, At, B1); PG8_BAR;
            PG8_LDB(B0, 1, 0); PG8_SCHED; PG8_LDA(At, 1, 0); PG8_STAGE(PG8_SA(0, 1), a2 + hstep, voffA);
            PG8_WAIT_L(8); PG8_BAR; PG8_WAIT_L(0); PG8_MMA(0, 0, At, B0); PG8_BAR; PG8_SCHED;
            PG8_LDB(B1, 1, 1); PG8_STAGE(PG8_SB(1, 0), b3, voffB);
            PG8_BAR; PG8_WAIT_L(0); PG8_MMA(0, 1, At, B1); PG8_BAR;
            PG8_LDA(At, 1, 1); PG8_STAGE(PG8_SA(1, 0), a3, voffA);
            PG8_BAR; PG8_WAIT_L(0); PG8_MMA(1, 0, At, B0); PG8_BAR; PG8_SCHED;
            PG8_STAGE(PG8_SB(1, 1), b3 + hstep, voffB);
            PG8_WAIT_V(6); PG8_BAR; PG8_MMA(1, 1, At, B1); PG8_BAR;
            }
        }
        if constexpr (ALIGN_EPI) { if (wr == 0) PG8_BAR; }
        if constexpr (!Epi::AFTER_DRAIN) { E(acc, cur, wr, wc, fr, fq); S.done(cur); }
        if (!has_next) break;
#pragma unroll
        for (int a = 0; a < 2; ++a)
#pragma unroll
            for (int b = 0; b < 2; ++b)
#pragma unroll
                for (int m = 0; m < 4; ++m)
#pragma unroll
                    for (int n = 0; n < 2; ++n) acc[a][b][m][n] = (f32x4){0.f, 0.f, 0.f, 0.f};
        cur = nxt; cA = nA; cB = nB; ++ui;
        if constexpr (ALIGN_EPI) { if (wr == 1) PG8_BAR; }
    }
    PG8_WAIT_V(0);
    if constexpr (!ALIGN_EPI) { if (wr == 0) PG8_BAR; }
    PG8_BAR;
    if constexpr (Epi::AFTER_DRAIN) { E.fused(acc, cur, wr, wc, fr, fq, lds, wid, lane); S.done(cur); }
#undef PG8_SA
#undef PG8_SB
#undef PG8_STAGE
#undef PG8_LDA
#undef PG8_LDB
#undef PG8_MMA
#undef PG8_WAIT_V
#undef PG8_WAIT_L
#undef PG8_BAR
#undef PG8_SCHED
}
}
#define LAS __attribute__((address_space(3)))
typedef unsigned short bf16;
typedef short bf16x8 __attribute__((ext_vector_type(8)));
typedef short s16x4 __attribute__((ext_vector_type(4)));
typedef float f32x4 __attribute__((ext_vector_type(4)));
typedef float f32x16 __attribute__((ext_vector_type(16)));
typedef unsigned u32x4 __attribute__((ext_vector_type(4)));
typedef unsigned u32x2 __attribute__((ext_vector_type(2)));

constexpr int NB = 4, NT = 2048, ND = 2048, NM = NB * NT;
constexpr int NF = 5632, NUP = 2 * NF;
constexpr int NIN_SRC = 9752, NIN = 9984;
constexpr float EPSF = 1e-6f, LOG2E = 1.4426950408889634f, QSCALE = 0.08838834764831845f * 1.4426950408889634f;
constexpr float LAM_INIT = 0.2f;
constexpr int NWAVES = 8, NTHR = 512;

constexpr size_t MiB = 1u << 20;
constexpr size_t WS_SMALL = 0;
constexpr size_t WS_WUP = 4 * MiB;
constexpr size_t WS_WDOWN = 48 * MiB;
constexpr size_t WS_WO = 70 * MiB;
constexpr size_t WS_WNSA = 78 * MiB;
constexpr size_t WS_WIN = 86 * MiB;
constexpr size_t WS_WC1 = 125 * MiB;
constexpr size_t WS_H = 127 * MiB;
constexpr size_t WS_MIX = 159 * MiB;
constexpr size_t WS_QN = 191 * MiB;
constexpr size_t WS_KV = 207 * MiB;
constexpr size_t WS_DQ = 231 * MiB;
constexpr size_t WS_DK = 247 * MiB;
constexpr size_t WS_DV = 263 * MiB;
constexpr size_t WS_MG = 279 * MiB;
constexpr size_t WS_ONSA = 343 * MiB;
constexpr size_t WS_HF = 375 * MiB;
constexpr size_t WS_HL = 378 * MiB;
constexpr size_t WS_END = 381 * MiB;
constexpr size_t WS_DTMP = 127 * MiB;
constexpr size_t WS_NSATMP = 86 * MiB;
constexpr size_t WS_ACT2 = 191 * MiB;
constexpr size_t SM_MOD = 0;
constexpr size_t SM_LAM = 262144;
constexpr size_t SM_CPART = 266240;
constexpr size_t SM_KC = 524288;
constexpr size_t SM_VC = 786432;
constexpr size_t SM_G = 1048576;
constexpr size_t SM_SLOTS = 2 * MiB;
constexpr size_t SM_BAR = 3 * MiB, SM_QCTR = SM_BAR + 16384, SM_PCNT = SM_QCTR + 1024, SM_BAR_BYTES = 16384 + 1024 + 32 * 256;
static_assert(SM_G + 786432 <= 4 * MiB, "small map");

constexpr int RING_BYTES = 131072;
constexpr int XL_OFF = 131072;
constexpr int LDS_BYTES = 157696;
constexpr int MISC_OFF = LDS_BYTES - 64;
constexpr int A_KBUF = 0, A_VBUF = 49152, A_WSCR = 147456, A_BIAS = 149504;
constexpr int A_IMPP = A_VBUF + 16384, A_IMPP2 = A_VBUF + 32768 + 16384, A_SC = A_VBUF + 65536 + 16384, A_SMASK = A_SC + 8448, A_UN = A_SMASK + 256;
static_assert(A_BIAS + 6528 + 32 <= LDS_BYTES - 64, "lds map");

__device__ const unsigned char T5_BUCKET[128] = {0, 1, 2, 3, 4, 5, 6, 7, 8, 9, 10, 11, 12, 13, 14, 15, 16, 16, 16, 17, 17, 18, 18, 18, 19, 19, 19, 20, 20, 20, 20, 21, 21, 21, 21, 22, 22, 22, 22, 22, 23, 23, 23, 23, 23, 23, 24, 24, 24, 24, 24, 24, 25, 25, 25, 25, 25, 25, 25, 26, 26, 26, 26, 26, 26, 26, 26, 27, 27, 27, 27, 27, 27, 27, 27, 27, 27, 28, 28, 28, 28, 28, 28, 28, 28, 28, 28, 29, 29, 29, 29, 29, 29, 29, 29, 29, 29, 29, 29, 30, 30, 30, 30, 30, 30, 30, 30, 30, 30, 30, 30, 30, 30, 31, 31, 31, 31, 31, 31, 31, 31, 31, 31, 31, 31, 31, 31, 31};

#define LDS_WAIT() asm volatile("s_waitcnt lgkmcnt(0)" ::: "memory")
#define VM_WAIT() asm volatile("s_waitcnt vmcnt(0)" ::: "memory")
__device__ __forceinline__ unsigned f2bf(float f) { unsigned u = __builtin_bit_cast(unsigned, f); return (u + 0x7fffu + ((u >> 16) & 1u)) >> 16; }
__device__ __forceinline__ unsigned pk2(float lo, float hi) { return f2bf(lo) | (f2bf(hi) << 16); }
__device__ __forceinline__ float bf2f(unsigned short h) { return __uint_as_float((unsigned)h << 16); }
__device__ __forceinline__ float wave_sum(float v) {
#pragma unroll
    for (int o = 1; o < 64; o <<= 1) v += __shfl_xor(v, o);
    return v;
}
__device__ __forceinline__ float silu_(float x) { return x / (1.0f + __expf(-x)); }
__device__ __forceinline__ float gelu_tanh_(float x) { const float y = 0.7978845608028654f * (x + 0.044715f * x * x * x); const float t = 1.0f - 2.0f / (__expf(2.0f * y) + 1.0f); return 0.5f * x * (1.0f + t); }

struct Args { const float* in[25]; float* out; unsigned char* ws; int ph_lo, ph_hi; };
typedef const __attribute__((address_space(4))) Args* ArgP;
__device__ __forceinline__ ArgP argp() { ArgP p = (ArgP)__builtin_amdgcn_kernarg_segment_ptr(); asm volatile("" : "+s"(p)); return p; }

__device__ __forceinline__ void p0_transpose_item(const float* W, int K  , int Nsrc, bf16* WT, int k0, int n0, int s0, int nvalid, LAS unsigned* scr, int lane, int kdst = 0  ) {
    const int kq = lane >> 4, nq = lane & 15;
    const bool ok = 4 * nq < nvalid;
    const float* src = W + (size_t)(k0 + 2 * kq) * Nsrc + s0 + 4 * nq;
    f32x4 v[8][2];
#pragma unroll
    for (int i = 0; i < 8; ++i)
#pragma unroll
        for (int h = 0; h < 2; ++h) v[i][h] = ok ? __builtin_nontemporal_load((const f32x4*)(src + (size_t)(8 * i + h) * Nsrc)) : (f32x4){0.f, 0.f, 0.f, 0.f};
#pragma unroll
    for (int i = 0; i < 8; ++i) { const int kp = 4 * i + kq;
#pragma unroll
        for (int e = 0; e < 4; ++e) scr[(4 * nq + e) * 33 + kp] = pk2(v[i][0][e], v[i][1][e]); }
    LDS_WAIT(); asm volatile("" ::: "memory");
    const int c = lane & 7;
#pragma unroll
    for (int j = 0; j < 8; ++j) { const int n = 8 * j + (lane >> 3); const LAS unsigned* s = scr + n * 33 + 4 * c;
        u32x4 o; o.x = s[0]; o.y = s[1]; o.z = s[2]; o.w = s[3];
        __builtin_nontemporal_store(o, (u32x4*)(WT + (size_t)(n0 + n) * K + kdst + k0 + 8 * c)); }
    LDS_WAIT(); asm volatile("" ::: "memory");
}
constexpr int WI_IN = 32 * (NIN / 64), WI_C1 = 64 * 2, WI_UP = 32 * (NUP / 64), WI_DN = (NF / 64) * (ND / 64), WI_O = 32 * 32, WI_NS = 16 * 32;
constexpr int WI_A = WI_IN + 2 * WI_C1, WI_B = WI_UP + WI_DN + WI_O + 2 * WI_NS;
__device__ __forceinline__ void weight_item_a(ArgP a, LAS unsigned* scr, int r, int lane) {
    unsigned char* ws = a->ws;
    if (r < WI_IN) { const int nb = r % (NIN / 64), kb = r / (NIN / 64), n0 = nb * 64; int s0, nv;
        if (n0 < 2560) { s0 = n0; nv = 64; } else if (n0 < 9728) { s0 = n0 + 24; nv = 64; } else if (n0 == 9728) { s0 = 2560; nv = 24; } else { s0 = 0; nv = 0; }
        p0_transpose_item(a->in[6], ND, NIN_SRC, (bf16*)(ws + WS_WIN), kb * 64, n0, s0, nv, scr, lane); return; } r -= WI_IN;
    { const int i = r / WI_C1, rr = r % WI_C1, nb = rr % 2, kb = rr / 2;
      p0_transpose_item(a->in[10] + (size_t)i * 4096 * 128, 4096, 128, (bf16*)(ws + WS_WC1) + (size_t)i * 128 * 4096, kb * 64, nb * 64, nb * 64, 64, scr, lane); }
}
__device__ __forceinline__ void weight_item_b(ArgP a, LAS unsigned* scr, int r, int lane) {
    unsigned char* ws = a->ws;
    if (r < WI_NS) { const int nb = r % 32, kb = r / 32; p0_transpose_item(a->in[17], 2048, ND, (bf16*)(ws + WS_WNSA), kb * 64, nb * 64, nb * 64, 64, scr, lane, 0); return; } r -= WI_NS;
    if (r < WI_NS) { const int nb = r % 32, kb = r / 32; p0_transpose_item(a->in[18], 2048, ND, (bf16*)(ws + WS_WNSA), kb * 64, nb * 64, nb * 64, 64, scr, lane, 1024); return; } r -= WI_NS;
    if (r < WI_O) { const int nb = r % 32, kb = r / 32; p0_transpose_item(a->in[19], ND, ND, (bf16*)(ws + WS_WO), kb * 64, nb * 64, nb * 64, 64, scr, lane); return; } r -= WI_O;
    if (r < WI_UP) { const int nb = r % (NUP / 64), kb = r / (NUP / 64), n0 = nb * 64; const int pn = n0 >> 8, rr = n0 & 255;
        const int s0 = (rr < 128) ? (pn * 128 + rr) : (NF + pn * 128 + rr - 128);
        p0_transpose_item(a->in[20], ND, NUP, (bf16*)(ws + WS_WUP), kb * 64, n0, s0, 64, scr, lane); return; } r -= WI_UP;
    { const int nb = r % (ND / 64), kb = r / (ND / 64); p0_transpose_item(a->in[23], NF, ND, (bf16*)(ws + WS_WDOWN), kb * 64, nb * 64, nb * 64, 64, scr, lane); }
}
__device__ __forceinline__ void p0_weights(ArgP a, LAS unsigned char* lds, int gw, int NGW, int wave, int lane) {
    LAS unsigned* scr = (LAS unsigned*)(lds + wave * 16384);
    for (int it = gw; it < WI_A; it += NGW) weight_item_a(a, scr, it, lane);
}
__device__ __forceinline__ void weights_b_queue(ArgP a, LAS unsigned char* lds, int wave, int lane) {
    LAS unsigned* scr = (LAS unsigned*)(lds + wave * 16384);
    unsigned* ctr = (unsigned*)(a->ws + WS_SMALL + SM_QCTR) + 2;
    for (;;) {
        unsigned c = 0; if (lane == 0) c = __hip_atomic_fetch_add(ctr, 1u, __ATOMIC_RELAXED, __HIP_MEMORY_SCOPE_AGENT);
        const int chunk = __builtin_amdgcn_readfirstlane((int)c);
        if (chunk * 8 >= WI_B) break;
        for (int k = 0; k < 8; ++k) { const int it = chunk * 8 + k; if (it < WI_B) weight_item_b(a, scr, it, lane); }
    }
}
__device__ __forceinline__ void p0_adaln(ArgP a, LAS unsigned char* lds, int tid) {
    LAS float* sc = (LAS float*)lds;
    LAS float* red = (LAS float*)(lds + 32768);
    const float* c = a->in[1]; const float* W = a->in[2]; const float* bias = a->in[3]; float* mod = (float*)(a->ws + WS_SMALL + SM_MOD);
    for (int i = tid; i < 4 * 2048; i += NTHR) sc[i] = silu_(c[i]);
    __syncthreads();
    for (int jb = blockIdx.x; jb < 256; jb += gridDim.x) {
        const int j0 = jb * 48, jq = tid % 12, kg = tid / 12;
        if (kg < 42) {
            f32x4 acc0 = {0, 0, 0, 0}, acc1 = acc0, acc2 = acc0, acc3 = acc0;
#pragma unroll 7
            for (int k = kg; k < 2048; k += 42) {
                const f32x4 w = *(const f32x4*)(W + (size_t)k * 12288 + j0 + jq * 4);
                acc0 += w * sc[k]; acc1 += w * sc[2048 + k]; acc2 += w * sc[4096 + k]; acc3 += w * sc[6144 + k];
            }
            LAS float* rp = red + kg * 192 + jq * 4;
            *(LAS f32x4*)(rp) = acc0; *(LAS f32x4*)(rp + 48) = acc1; *(LAS f32x4*)(rp + 96) = acc2; *(LAS f32x4*)(rp + 144) = acc3;
        }
        __syncthreads();
        if (tid < 192) { float s = 0.f; for (int g = 0; g < 42; ++g) s += red[g * 192 + tid]; const int b = tid / 48, j = j0 + tid % 48; mod[b * 12288 + j] = s + bias[j]; }
        __syncthreads();
    }
}
__device__ __forceinline__ void p0_small(ArgP a, int tid) {
    unsigned char* ws = a->ws;
    if (blockIdx.x == 0 && tid < 64) {
        const float* lq = a->in[14]; const float* lk = a->in[15];
        const float s0 = wave_sum(lq[tid] * lk[tid] + lq[64 + tid] * lk[64 + tid]);
        const float s1 = wave_sum(lq[128 + tid] * lk[128 + tid] + lq[192 + tid] * lk[192 + tid]);
        if (tid == 0) *(float*)(ws + WS_SMALL + SM_LAM) = __expf(s0) - __expf(s1) + LAM_INIT;
    }
    for (int kc = blockIdx.x; kc < 32; kc += gridDim.x) {
        if (tid < 256) { const int i = tid >> 7, n = tid & 127; const float* pe = a->in[9] + i * 4096 + kc * 128; const float* w1 = a->in[10] + ((size_t)i * 4096 + kc * 128) * 128 + n;
            float s = 0.f;
#pragma unroll 8
            for (int k = 0; k < 128; ++k) s += pe[k] * w1[(size_t)k * 128];
            ((float*)(ws + WS_SMALL + SM_CPART))[kc * 256 + tid] = s; }
    }
    { const int g = blockIdx.x * NTHR + tid; if (g < 8 * 128) { const int bg = g >> 7, d = g & 127;
        ((bf16*)(ws + WS_SMALL + SM_KC))[(bg * 128 + 127) * 128 + d] = 0; ((bf16*)(ws + WS_SMALL + SM_VC))[(bg * 128 + 127) * 128 + d] = 0; } }
}

__device__ __forceinline__ void norm_rows(const float* X, const float* gain, const float* sh, const float* scl, bf16* H, int gw, int NGW, int lane) {
    for (int row = gw; row < NM; row += NGW) {
        const int b = row >> 11;
        const f32x4* xr = (const f32x4*)(X + (size_t)row * ND) + lane;
        f32x4 v[8]; float s = 0.f;
#pragma unroll
        for (int j = 0; j < 8; ++j) { v[j] = xr[64 * j]; s += (v[j][0] * v[j][0] + v[j][1] * v[j][1]) + (v[j][2] * v[j][2] + v[j][3] * v[j][3]); }
        const float rs = rsqrtf(wave_sum(s) * (1.0f / ND) + EPSF);
        u32x2* o = (u32x2*)(H + (size_t)row * ND) + lane;
#pragma unroll
        for (int j = 0; j < 8; ++j) { const int c = 256 * j + 4 * lane;
            const f32x4 g = *(const f32x4*)(gain + c), a1 = *(const f32x4*)(scl + b * 12288 + c), a0 = *(const f32x4*)(sh + b * 12288 + c);
            const f32x4 y = v[j] * rs * g * (a1 + 1.0f) + a0;
            u32x2 w; w.x = pk2(y[0], y[1]); w.y = pk2(y[2], y[3]); o[64 * j] = w; }
    }
}

__device__ __forceinline__ void act_fixup(const float* HF, const float* HL, const float* cw, const float* cb, bf16* ACT, int pm, int tid) {
    if ((pm & 7) == 0) return;
    const float* f0 = HF + (size_t)(pm * 2) * NUP; const float* f1 = f0 + NUP;
    const float* l0 = HL + (size_t)((pm - 1) * 2) * NUP; const float* l1 = l0 + NUP;
    for (int j = tid; j < NF; j += NTHR) {
        const int ca = (j >> 7) * 256 + (j & 127), cv = ca + 128;
        const float wa0 = cw[j], wa1 = cw[NUP + j], wa2 = cw[2 * NUP + j], wv0 = cw[NF + j], wv1 = cw[NUP + NF + j], wv2 = cw[2 * NUP + NF + j], ba = cb[j], bv = cb[NF + j];
        const float a_m2 = l0[ca], a_m1 = l1[ca], a_0 = f0[ca], a_1 = f1[ca], v_m2 = l0[cv], v_m1 = l1[cv], v_0 = f0[cv], v_1 = f1[cv];
        const float c0a = ba + wa0 * a_m2 + wa1 * a_m1 + wa2 * a_0, c0v = bv + wv0 * v_m2 + wv1 * v_m1 + wv2 * v_0;
        const float c1a = ba + wa0 * a_m1 + wa1 * a_0 + wa2 * a_1, c1v = bv + wv0 * v_m1 + wv1 * v_0 + wv2 * v_1;
        ACT[(size_t)(pm * 256) * NF + j] = (bf16)f2bf(silu_(c0a) * c0v);
        ACT[(size_t)(pm * 256 + 1) * NF + j] = (bf16)f2bf(silu_(c1a) * c1v);
    }
}
#define XB_TMO      128
#define XB_XCNT(j)  (256  + 64 * (j))
#define XB_XSUB(j)  (1280 + 64 * (j))
#define XB_XGEN(j)  (2304 + 64 * (j))
#define XB_TOP      3328
#define XB_TOPGEN   3392
#define XCD_BAR_WORDS 3456
#define XB_SPIN_CAP (1u << 18)

__device__ __forceinline__ unsigned xb_ld(unsigned* p)              { return __hip_atomic_load(p, __ATOMIC_RELAXED, __HIP_MEMORY_SCOPE_AGENT); }
__device__ __forceinline__ unsigned xb_add(unsigned* p, unsigned v) { return __hip_atomic_fetch_add(p, v, __ATOMIC_RELAXED, __HIP_MEMORY_SCOPE_AGENT); }
__device__ __forceinline__ unsigned xb_xcc_id() { return (unsigned)__builtin_amdgcn_s_getreg((3 << 11) | 20) & 0xFu; }
#define XB_SPIN(cond, bar) do { unsigned _sp = 0; while (cond) { __builtin_amdgcn_s_sleep(1); \
    if ((++_sp & 255u) == 0u) { if (xb_ld(&(bar)[XB_TMO])) break; if (_sp > XB_SPIN_CAP) { atomicAdd(&(bar)[XB_TMO], 1u); break; } } } } while (0)

struct XcdBarrier {
    unsigned* bar; unsigned x;
    volatile LAS unsigned* st;
};

__device__ __forceinline__ XcdBarrier xcd_barrier_post(unsigned* bar, volatile LAS unsigned* st, int tid) {
    XcdBarrier b; b.bar = bar; b.x = xb_xcc_id(); b.st = st;
    if (tid == 0) (void)xb_add(&bar[XB_XCNT(b.x)], 1u);
    return b;
}
__device__ __forceinline__ void xcd_barrier_complete(unsigned* bar, unsigned x, unsigned& nloc, unsigned& nx) {
    const unsigned G = gridDim.x * gridDim.y * gridDim.z;
    unsigned sum, cnt, mine, sp = 0u;
    for (;;) {
        sum = 0u; cnt = 0u; mine = 0u;
#pragma unroll
        for (unsigned j = 0; j < 16; ++j) { const unsigned c = xb_ld(&bar[XB_XCNT(j)]); sum += c; cnt += (c > 0u) ? 1u : 0u; mine = (j == x) ? c : mine; }
        if (sum == G) break;
        __builtin_amdgcn_s_sleep(1);
        if ((++sp & 255u) == 0u) { if (xb_ld(&bar[XB_TMO])) break; if (sp > XB_SPIN_CAP) { atomicAdd(&bar[XB_TMO], 1u); break; } }
    }
    nloc = mine > 0u ? mine : 1u; nx = cnt > 0u ? cnt : 1u;
}

__device__ __forceinline__ void xcd_barrier(const XcdBarrier& b, int tid) {
    asm volatile("s_waitcnt vmcnt(0)" ::: "memory");
    __syncthreads();
    if (tid == 0) {
        unsigned* bar = b.bar;
        __builtin_amdgcn_s_waitcnt(0);
        unsigned nloc = b.st[0], nx = b.st[1];
        if (nloc == 0u) { xcd_barrier_complete(bar, b.x, nloc, nx); b.st[0] = nloc; b.st[1] = nx; }
        const unsigned old = xb_add(&bar[XB_XSUB(b.x)], 1u);
        const unsigned gen = old / nloc;
        if (old + 1u == (gen + 1u) * nloc) {
            __builtin_amdgcn_fence(__ATOMIC_RELEASE, "agent");
            asm volatile("s_waitcnt vmcnt(0)" ::: "memory");
            const unsigned og = xb_add(&bar[XB_TOP], 1u);
            const unsigned tg = og / nx;
            if (og + 1u == (tg + 1u) * nx) xb_add(&bar[XB_TOPGEN], 1u);
            else XB_SPIN(xb_ld(&bar[XB_TOPGEN]) == tg, bar);
            __builtin_amdgcn_fence(__ATOMIC_ACQUIRE, "agent");
            xb_add(&bar[XB_XGEN(b.x)], 1u);
            asm volatile("s_waitcnt vmcnt(0)" ::: "memory");
        } else {
            XB_SPIN(xb_ld(&bar[XB_XGEN(b.x)]) == gen, bar);
            __builtin_amdgcn_fence(__ATOMIC_ACQUIRE, "agent");
            asm volatile("s_waitcnt vmcnt(0)" ::: "memory");
        }
    }
    __syncthreads();
}
namespace att {
constexpr int SHM_K = 16384, SHM_V = 16384;
constexpr float SM_THR = 8.0f;
#define KSWZ(row, colB) ((row) * 256 + ((colB) ^ (((row) & 7) << 4)))
#define SBAR() __builtin_amdgcn_sched_barrier(0)
__device__ __forceinline__ int v_st(int k, int c) { const int kk = (k & ~0xC) | ((k & 4) << 1) | ((k & 8) >> 1); return ((kk >> 3) * 4 + (c >> 5)) * 512 + ((kk & 7) * 32 + (c & 31)) * 2; }
__device__ __forceinline__ int v_rd_base(int lane) { return ((lane & 3) << 3) | (((lane >> 2) & 3) << 6) | (((lane >> 4) & 1) << 5) | (((lane >> 5) & 1) << 8); }
constexpr int v_rd_off(int d0, int ks, int half) { return d0 * 512 + ks * 4096 + half * 2048; }
__device__ __forceinline__ int crow(int r, int hi) { return (r & 3) + 8 * (r >> 2) + 4 * hi; }
__device__ __forceinline__ unsigned cvtpk(float lo, float hi) { unsigned r; asm volatile("v_cvt_pk_bf16_f32 %0, %1, %2" : "=v"(r) : "v"(lo), "v"(hi)); return r; }

__device__ __forceinline__ void qkt(f32x16& p0, f32x16& p1, const LAS char* Kb, int r32, int hi, const bf16x8* qr) {
    p0 = f32x16{}; p1 = f32x16{};
    int ka[4];
#pragma unroll
    for (int dd = 0; dd < 4; ++dd) ka[dd] = (int)(unsigned)(uintptr_t)(Kb + KSWZ(r32, (dd * 16 + hi * 8) * 2));
#define DSR128(dst, addr, off) asm volatile("ds_read_b128 %0, %1 offset:%2" : "=v"(dst) : "v"(addr), "i"(off) : "memory")
    bf16x8 kf[8];
#pragma unroll
    for (int hf = 0; hf < 2; ++hf) {
#pragma unroll
        for (int dd = 0; dd < 4; ++dd) { if (hf == 0) { DSR128(kf[2 * dd], ka[dd], 0); DSR128(kf[2 * dd + 1], ka[dd], 8192); } else { DSR128(kf[2 * dd], ka[dd], 128); DSR128(kf[2 * dd + 1], ka[dd], 8192 + 128); } }
        asm volatile("s_waitcnt lgkmcnt(0)" ::: "memory"); SBAR();
#pragma unroll
        for (int dd = 0; dd < 4; ++dd) {
            p0 = __builtin_amdgcn_mfma_f32_32x32x16_bf16(kf[2 * dd], qr[4 * hf + dd], p0, 0, 0, 0);
            p1 = __builtin_amdgcn_mfma_f32_32x32x16_bf16(kf[2 * dd + 1], qr[4 * hf + dd], p1, 0, 0, 0); }
        SBAR();
    }
#undef DSR128
}
__device__ __forceinline__ void pv_tile(f32x16* o, int vb0, bf16x8 pa0, bf16x8 pa1, bf16x8 pa2, bf16x8 pa3) {
#define TRRD(dst, off) asm volatile("ds_read_b64_tr_b16 %0, %1 offset:%2" : "=&v"(dst) : "v"(vb0), "i"(off) : "memory")
#define PV_RD(S, d0) do { constexpr int b_ = v_rd_off(d0, 0, 0); \
        TRRD(S##l0, b_); TRRD(S##h0, b_ + 2048); TRRD(S##l1, b_ + 4096); TRRD(S##h1, b_ + 6144); TRRD(S##l2, b_ + 8192); TRRD(S##h2, b_ + 10240); TRRD(S##l3, b_ + 12288); TRRD(S##h3, b_ + 14336); } while (0)
#define PV_MM(S, d0) do { \
        o[d0] = __builtin_amdgcn_mfma_f32_32x32x16_bf16(pa0, (bf16x8){S##l0[0], S##l0[1], S##l0[2], S##l0[3], S##h0[0], S##h0[1], S##h0[2], S##h0[3]}, o[d0], 0, 0, 0);   \
        o[d0] = __builtin_amdgcn_mfma_f32_32x32x16_bf16(pa1, (bf16x8){S##l1[0], S##l1[1], S##l1[2], S##l1[3], S##h1[0], S##h1[1], S##h1[2], S##h1[3]}, o[d0], 0, 0, 0);   \
        o[d0] = __builtin_amdgcn_mfma_f32_32x32x16_bf16(pa2, (bf16x8){S##l2[0], S##l2[1], S##l2[2], S##l2[3], S##h2[0], S##h2[1], S##h2[2], S##h2[3]}, o[d0], 0, 0, 0);   \
        o[d0] = __builtin_amdgcn_mfma_f32_32x32x16_bf16(pa3, (bf16x8){S##l3[0], S##l3[1], S##l3[2], S##l3[3], S##h3[0], S##h3[1], S##h3[2], S##h3[3]}, o[d0], 0, 0, 0); } while (0)
#define PV_W8() do { asm volatile("s_waitcnt lgkmcnt(8)" ::: "memory"); SBAR(); } while (0)
#define PV_W0() do { asm volatile("s_waitcnt lgkmcnt(0)" ::: "memory"); SBAR(); } while (0)
    s16x4 Al0, Al1, Al2, Al3, Ah0, Ah1, Ah2, Ah3, Bl0, Bl1, Bl2, Bl3, Bh0, Bh1, Bh2, Bh3;
    PV_RD(A, 0); SBAR(); PV_RD(B, 1); PV_W8(); PV_MM(A, 0); SBAR();
    PV_RD(A, 2); PV_W8(); PV_MM(B, 1); SBAR();
    PV_RD(B, 3); PV_W8(); PV_MM(A, 2); SBAR();
    PV_W0(); PV_MM(B, 3);
#undef PV_RD
#undef PV_MM
#undef PV_W8
#undef PV_W0
#undef TRRD
}
__device__ __forceinline__ void pack_p(const f32x16& p0, const f32x16& p1, bf16x8& pa0, bf16x8& pa1, bf16x8& pa2, bf16x8& pa3) {
#define PK4(P, B_, OUT) do { unsigned a0 = cvtpk(P[B_+0], P[B_+1]), a1 = cvtpk(P[B_+2], P[B_+3]);                          \
        unsigned b0 = cvtpk(P[B_+4], P[B_+5]), b1 = cvtpk(P[B_+6], P[B_+7]);                                             \
        auto r0 = __builtin_amdgcn_permlane32_swap(a0, b0, false, false); auto r1 = __builtin_amdgcn_permlane32_swap(a1, b1, false, false); \
        u32x4 w = {r0[0], r1[0], r0[1], r1[1]}; OUT = *reinterpret_cast<bf16x8*>(&w); } while (0)
    PK4(p0, 0, pa0); PK4(p0, 8, pa1); PK4(p1, 0, pa2); PK4(p1, 8, pa3);
#undef PK4
}
__device__ __forceinline__ float xhalf_max(float v) { auto rr = __builtin_amdgcn_permlane32_swap(__float_as_uint(v), __float_as_uint(v), false, false); return fmaxf(__uint_as_float(rr[0]), __uint_as_float(rr[1])); }
__device__ __forceinline__ float xhalf_sum(float v) { auto rr = __builtin_amdgcn_permlane32_swap(__float_as_uint(v), __float_as_uint(v), false, false); return __uint_as_float(rr[0]) + __uint_as_float(rr[1]); }

template <bool USE_TAB>
__device__ __forceinline__ void xform(f32x16& p0, f32x16& p1, int dq0, unsigned W, bool rowok, float cb, const LAS float* tab  ) {
    const float NEG = -__builtin_inff();
#pragma unroll
    for (int q = 0; q < 4; ++q) {
        const int db0 = dq0 - 8 * q, db1 = db0 - 32;
        float b0[4] = {cb, cb, cb, cb}, b1[4] = {cb, cb, cb, cb};
        if (USE_TAB) {
            const int c0 = db0 < 0 ? 0 : (db0 > 130 ? 130 : db0), c1 = db1 < 0 ? 0 : (db1 > 130 ? 130 : db1);
            const LAS float* t0 = tab + c0; const LAS float* t1 = tab + c1;
#pragma unroll
            for (int e = 0; e < 4; ++e) { b0[e] = t0[3 - e]; b1[e] = t1[3 - e]; asm volatile("" : "+v"(b0[e]), "+v"(b1[e])); }
        }
#pragma unroll
        for (int e = 0; e < 4; ++e) { const int r = 4 * q + e;
            p0[r] = (rowok && (unsigned)(db0 - e) < W) ? p0[r] + b0[e] : NEG;
            p1[r] = (rowok && (unsigned)(db1 - e) < W) ? p1[r] + b1[e] : NEG; }

    }
}
__device__ __forceinline__ void sm_step_c(f32x16& p0, f32x16& p1, float& l, bf16x8& pa0, bf16x8& pa1, bf16x8& pa2, bf16x8& pa3, float off) {
    float ps = 0.f;
#pragma unroll
    for (int r = 0; r < 16; ++r) { p0[r] = __builtin_amdgcn_exp2f(p0[r] + off); p1[r] = __builtin_amdgcn_exp2f(p1[r] + off); ps += p0[r] + p1[r]; }
    ps = xhalf_sum(ps);
    l += ps;
    pack_p(p0, p1, pa0, pa1, pa2, pa3);
}
template <int ND4>
__device__ __forceinline__ void scale_rows(f32x16* o, float f, LAS float* wscr  , int r32, int hi) {
    if (hi == 0) wscr[r32] = f;
    asm volatile("s_waitcnt lgkmcnt(0)" ::: "memory");
    float fr[16];
#pragma unroll
    for (int r = 0; r < 16; ++r) fr[r] = wscr[crow(r, hi)];
#pragma unroll
    for (int d = 0; d < ND4; ++d)
#pragma unroll
        for (int r = 0; r < 16; ++r) o[d][r] *= fr[r];
    asm volatile("s_waitcnt lgkmcnt(0)" ::: "memory");
}
__device__ __forceinline__ int k_dma_off(int wave, int lane, int ldk) { const int row = wave * 4 + (lane >> 4); const int ch = (lane & 15) ^ (row & 7); return row * ldk + ch * 8; }
__device__ __forceinline__ int v_dma_off(int wave, int lane, int ldv) { const int st = wave * 2 + (lane >> 5); const int kk = (st >> 2) * 8 + ((lane & 31) >> 2);
    const int k = (kk & ~0xC) | ((kk & 4) << 1) | ((kk & 8) >> 1); const int c = (st & 3) * 32 + (lane & 3) * 8; return k * ldv + c; }
__device__ __forceinline__ void glds16(const bf16* src, LAS char* dst) { __builtin_amdgcn_global_load_lds((const unsigned*)src, (LAS unsigned*)dst, 16, 0, 0); }
template <int NV>
__device__ __forceinline__ void tile_dma(const bf16* Kt, int ldk, const bf16* Vt, int ldv, int kofs, int vofs, LAS char* Kb, LAS char* Vb, int wave) {
    glds16(Kt + kofs, Kb + wave * 1024); glds16(Kt + kofs + 32 * ldk, Kb + 8192 + wave * 1024);
    glds16(Vt + vofs, Vb + wave * 1024); glds16(Vt + vofs + 32 * ldv, Vb + 8192 + wave * 1024);
    if (NV == 2) { glds16(Vt + 128 + vofs, Vb + SHM_V + wave * 1024); glds16(Vt + 128 + vofs + 32 * ldv, Vb + SHM_V + 8192 + wave * 1024); }
}
struct Stage1 { bf16x8 k0, k1, v0, v1; };
__device__ __forceinline__ void stage_load(Stage1& S, const bf16* Kp, const bf16* Vp, int sr, int sc) {
    S.k0 = *(const bf16x8*)(Kp + sr * 128 + sc); S.k1 = *(const bf16x8*)(Kp + (sr + 32) * 128 + sc);
    S.v0 = *(const bf16x8*)(Vp + sr * 128 + sc); S.v1 = *(const bf16x8*)(Vp + (sr + 32) * 128 + sc);
}
__device__ __forceinline__ void stage_write(const Stage1& S, LAS char* Kb, LAS char* Vb, int kws, int vst0, int vst1) {
    *(LAS bf16x8*)(Kb + kws) = S.k0; *(LAS bf16x8*)(Kb + kws + 32 * 256) = S.k1;
    *(LAS bf16x8*)(Vb + vst0) = S.v0; *(LAS bf16x8*)(Vb + vst1) = S.v1;
}
constexpr int OSTG_BYTES = 32 * 132 * 4;
__device__ __forceinline__ void ostage_write(const f32x16* o, LAS float* wb, int r32, int hi) {
#pragma unroll
    for (int r = 0; r < 16; ++r)
#pragma unroll
        for (int d = 0; d < 4; ++d) wb[crow(r, hi) * 132 + d * 32 + r32] = o[d][r];
    asm volatile("s_waitcnt lgkmcnt(0)" ::: "memory");
}
__device__ __forceinline__ f32x4 ostage_read(const LAS float* wb, int i, int lane) { const int idx = i * 64 + lane; return *(const LAS f32x4*)(wb + (idx >> 5) * 132 + (idx & 31) * 4); }
}

constexpr int BT_STRIDE = 136;
__device__ __forceinline__ float wave_max(float v) {
#pragma unroll
    for (int o = 1; o < 64; o <<= 1) v = fmaxf(v, __shfl_xor(v, o));
    return v;
}
__device__ __forceinline__ void build_bias(ArgP a, LAS float* tab, int tid) {
    const float* rel_bias = a->in[24];
    for (int i = tid; i < 12 * BT_STRIDE; i += NTHR) { const int hd = i / BT_STRIDE, x = i % BT_STRIDE; int d = x - 3; d = d < 0 ? 0 : (d > 127 ? 127 : d); tab[i] = rel_bias[T5_BUCKET[d] * 12 + hd] * LOG2E; }
    if (tid < 64) {
        const float* gq = a->in[7]; const float* gk = a->in[8]; const float* dq = a->in[12]; const float* dk = a->in[13];
        const float mq = wave_max(fmaxf(fabsf(gq[tid]), fabsf(gq[64 + tid]))), mdq = wave_max(fmaxf(fabsf(dq[tid]), fabsf(dq[64 + tid]))), mdk = wave_max(fmaxf(fabsf(dk[tid]), fabsf(dk[64 + tid])));
        const float mk0 = wave_max(fmaxf(fabsf(gk[tid]), fabsf(gk[64 + tid]))), mk1 = wave_max(fmaxf(fabsf(gk[128 + tid]), fabsf(gk[192 + tid]))), mk2 = wave_max(fmaxf(fabsf(gk[256 + tid]), fabsf(gk[320 + tid])));
        float mb = 0.f; for (int i = tid; i < 384; i += 64) mb = fmaxf(mb, fabsf(rel_bias[i])); mb = wave_max(mb) * LOG2E + 1.0f;
        const float K = 1.03f * 128.0f * QSCALE;
        LAS float* cbv = tab + 12 * BT_STRIDE;
        if (tid == 0) { cbv[0] = fminf(K * mdq * mdk + mb, 100.f); cbv[1] = fminf(K * mq * mk0 + mb, 100.f); cbv[2] = fminf(K * mq * mk1 + mb, 100.f); cbv[3] = fminf(K * mq * mk2 + mb, 100.f); }
    }
}

__device__ __forceinline__ void diff_item(ArgP a, LAS unsigned char* lds_g, int item, int tid, int lane, int wave) {
    using namespace att;
    unsigned char* ws = a->ws;
    const int qi = 15 - (item >> 5), rest = item & 31, mp = rest & 1, h = (rest >> 1) & 3, b = rest >> 3;
    const int r32 = lane & 31, hi = lane >> 5, rg = wave >> 1, vh = wave & 1;
    const bf16* DQ = (const bf16*)(ws + WS_DQ); const bf16* DK = (const bf16*)(ws + WS_DK); const bf16* DV = (const bf16*)(ws + WS_DV);
    float* On = (float*)(ws + WS_DTMP) + (size_t)mp * NM * 1024;
    const int tq = qi * 128 + rg * 32 + r32;
    const size_t rowbase = (size_t)b * NT;
    bf16x8 qr[8];
    { const bf16* qp = DQ + ((size_t)(h * 2 + mp) * NM + rowbase + tq) * 128 + hi * 8;
#pragma unroll
      for (int d0 = 0; d0 < 8; ++d0) qr[d0] = *(const bf16x8*)(qp + d0 * 16); }
    const bf16* Kg = DK + ((size_t)(h * 2 + mp) * NM + rowbase) * 128;
    const bf16* Vg = DV + ((size_t)h * NM + rowbase) * 256;
    const int kofs = k_dma_off(wave, lane, 128), vofs = v_dma_off(wave, lane, 256);
    LAS char* L = (LAS char*)lds_g;
    LAS float* wscr = (LAS float*)(L + A_WSCR) + wave * 64;
    const LAS float* tab = (const LAS float*)(L + A_BIAS) + (8 + h) * BT_STRIDE;
    const float cb = tab[130];
    const float CB = ((const LAS float*)(L + A_BIAS))[12 * BT_STRIDE + 0];
    const int vrb = v_rd_base(lane) + vh * SHM_V;
    LAS char* PX = L + A_VBUF + 4 * SHM_V + rg * 4096 + lane * 64;
    f32x16 o[4];
#pragma unroll
    for (int d = 0; d < 4; ++d) o[d] = f32x16{};
    float l = 0.f;
    const int NTI = 2 * qi + 2;
#define DMA_K(t_, s_) do { glds16(Kg + (size_t)(t_) * 64 * 128 + kofs, L + A_KBUF + (s_) * SHM_K + wave * 1024); glds16(Kg + (size_t)(t_) * 64 * 128 + kofs + 32 * 128, L + A_KBUF + (s_) * SHM_K + 8192 + wave * 1024); } while (0)
#define DMA_V(t_, s_) do { const bf16* vt_ = Vg + (size_t)(t_) * 64 * 256 + vofs; LAS char* vb_ = L + A_VBUF + (s_) * 2 * SHM_V + wave * 1024; \
        glds16(vt_, vb_); glds16(vt_ + 32 * 256, vb_ + 8192); glds16(vt_ + 128, vb_ + SHM_V); glds16(vt_ + 128 + 32 * 256, vb_ + SHM_V + 8192); } while (0)
    DMA_K(0, 0); DMA_V(0, 0); DMA_K(1, 1);
#pragma unroll
    for (int d0 = 0; d0 < 8; ++d0) asm volatile("" : "+v"(qr[d0]));
    bf16x8 pk0 = {}, pk1 = {}, pk2 = {}, pk3 = {};
    for (int t = 0; t <= NTI; ++t) {
        if (t == 0) asm volatile("s_waitcnt vmcnt(6)" ::: "memory");
        else if (t + 1 < NTI) asm volatile("s_waitcnt vmcnt(2)" ::: "memory");
        else asm volatile("s_waitcnt vmcnt(0)" ::: "memory");
        __builtin_amdgcn_s_barrier(); asm volatile("" ::: "memory");
        if (t >= 1 && t < NTI) DMA_V(t, t & 1);
        if (t + 2 < NTI) DMA_K(t + 2, (t + 2) % 3);
        const bool prod = (t < NTI) && ((((t + (rg >> 1)) & 1)) == vh);
        const bool prev_mine = (t >= 1) && ((((t - 1 + (rg >> 1)) & 1)) == vh);
        bf16x8 pa0 = pk0, pa1 = pk1, pa2 = pk2, pa3 = pk3;
        if (t >= 1 && !prev_mine) { pa0 = *(const LAS bf16x8*)(PX); pa1 = *(const LAS bf16x8*)(PX + 16); pa2 = *(const LAS bf16x8*)(PX + 32); pa3 = *(const LAS bf16x8*)(PX + 48);
            asm volatile("s_waitcnt lgkmcnt(0)" ::: "memory"); }
        if (prod) {
            f32x16 p0, p1;
            qkt(p0, p1, L + A_KBUF + (t % 3) * SHM_K, r32, hi, qr);
            float cbias = cb;
            if (t >= 2 * qi - 2) { xform<true>(p0, p1, tq - t * 64 - 4 * hi, 0x7fffffffu, true, cb, tab); cbias = 0.f; }
            sm_step_c(p0, p1, l, pk0, pk1, pk2, pk3, cbias - CB);
            *(LAS bf16x8*)(PX) = pk0; *(LAS bf16x8*)(PX + 16) = pk1; *(LAS bf16x8*)(PX + 32) = pk2; *(LAS bf16x8*)(PX + 48) = pk3;
            asm volatile("s_waitcnt lgkmcnt(0)" ::: "memory");
        }
        if (t >= 1) pv_tile(o, (int)(unsigned)(uintptr_t)(L + A_VBUF + ((t - 1) & 1) * 2 * SHM_V) + vrb, pa0, pa1, pa2, pa3);
    }
#undef DMA_K
#undef DMA_V
    if (hi == 0) wscr[32 + r32] = l;
    asm volatile("s_waitcnt lgkmcnt(0)" ::: "memory"); __builtin_amdgcn_s_barrier(); asm volatile("" ::: "memory");
    { const LAS float* pw = (const LAS float*)(L + A_WSCR) + (wave ^ 1) * 64; l += pw[32 + r32]; }
    scale_rows<4>(o, 1.0f / l, wscr, r32, hi);
    unsigned ob = (unsigned)((rowbase + qi * 128 + rg * 32 + 4 * hi) * 1024 + h * 256 + vh * 128 + r32); asm volatile("" : "+v"(ob));
#pragma unroll
    for (int r = 0; r < 16; ++r) { float* rp = On + ((size_t)ob + (unsigned)(((r & 3) + 8 * (r >> 2)) * 1024));
#pragma unroll
        for (int d = 0; d < 4; ++d) rp[d * 32] = o[d][r]; }
}

__device__ __forceinline__ void compress_item(ArgP a, LAS unsigned char* lds_g, int item, int tid, int lane, int wave) {
    unsigned char* ws = a->ws;
    const int i = item >> 5, rb = item & 31;
    const int r32 = lane & 31, hi = lane >> 5, ct = wave & 3, kh = wave >> 2;
    const bf16* KV = (const bf16*)(ws + WS_KV); const bf16* W1T = (const bf16*)(ws + WS_WC1) + (size_t)i * 128 * 4096;
    LAS char* L = (LAS char*)lds_g;
    LAS float* red = (LAS float*)L;
    LAS float* hb = (LAS float*)(L + 16384);
    LAS float* cv = (LAS float*)(L + 32768);
    if (tid < 128) { const float* cp = (const float*)(ws + WS_SMALL + SM_CPART) + i * 128 + tid; float s = 0.f; for (int kc = 0; kc < 32; ++kc) s += cp[kc * 256]; cv[tid] = s; }
    int R = rb * 32 + r32; if (R > 1015) R = 1015;
    const int b = R / 254, rem = R % 254, c = rem >> 1, g = rem & 1;
    const bf16* ap = KV + ((size_t)(i * 2 + g) * NM + (size_t)b * NT + 16 * c + 16 * kh) * 128 + 8 * hi;
    const bf16* bp = W1T + (size_t)(32 * ct + r32) * 4096 + 2048 * kh + 8 * hi;
    f32x16 acc = f32x16{};
#pragma unroll 8
    for (int kk = 0; kk < 128; ++kk) {
        const bf16x8 af = *(const bf16x8*)(ap + (size_t)(kk >> 3) * 128 + (kk & 7) * 16);
        const bf16x8 bf = *(const bf16x8*)(bp + kk * 16);
        acc = __builtin_amdgcn_mfma_f32_32x32x16_bf16(af, bf, acc, 0, 0, 0);
    }
    if (kh == 1) {
#pragma unroll
        for (int r = 0; r < 16; ++r) red[(ct * 16 + r) * 64 + lane] = acc[r]; }
    __syncthreads();
    if (kh == 0) {
#pragma unroll
        for (int r = 0; r < 16; ++r) { const float v = acc[r] + red[(ct * 16 + r) * 64 + lane] + cv[32 * ct + r32];
            hb[att::crow(r, hi) * 128 + 32 * ct + r32] = gelu_tanh_(v); } }
    __syncthreads();
    const int row = tid >> 4, n2 = (tid & 15) * 8;
    const float* w2 = a->in[11] + (size_t)i * 128 * 128 + n2;
    f32x4 s0 = {0, 0, 0, 0}, s1 = s0;
#pragma unroll 4
    for (int n = 0; n < 128; ++n) { const float hv = hb[row * 128 + n]; s0 += *(const f32x4*)(w2 + n * 128) * hv; s1 += *(const f32x4*)(w2 + n * 128 + 4) * hv; }
    if (i == 0) {
        float ss = (s0[0] * s0[0] + s0[1] * s0[1]) + (s0[2] * s0[2] + s0[3] * s0[3]) + (s1[0] * s1[0] + s1[1] * s1[1]) + (s1[2] * s1[2] + s1[3] * s1[3]);
        ss += __shfl_xor(ss, 1); ss += __shfl_xor(ss, 2); ss += __shfl_xor(ss, 4); ss += __shfl_xor(ss, 8);
        const float rs = rsqrtf(ss * (1.0f / 128.0f) + EPSF);
        const f32x4 g0 = *(const f32x4*)(a->in[8] + n2), g1 = *(const f32x4*)(a->in[8] + n2 + 4);
        s0 = s0 * rs * g0; s1 = s1 * rs * g1;
    }
    const int Ro = rb * 32 + row;
    if (Ro < 1016) { const int bo = Ro / 254, remo = Ro % 254, co = remo >> 1, go = remo & 1;
        bf16* dst = (bf16*)(ws + WS_SMALL + (i == 0 ? SM_KC : SM_VC)) + ((size_t)(bo * 2 + go) * 128 + co) * 128 + n2;
        pg8::st8_bf16(dst, s0, s1); }
    __syncthreads();
}

__device__ __forceinline__ void phase3(ArgP a, LAS unsigned char* lds, int tid, int lane, int wave) {
    LAS unsigned char* lds_g = lds;
    build_bias(a, (LAS float*)(lds_g + A_BIAS), tid);
    unsigned* ctr = (unsigned*)(a->ws + WS_SMALL + SM_QCTR);
    volatile LAS unsigned* slot = (volatile LAS unsigned*)(lds_g + MISC_OFF + 16);
    if (tid == 0) slot[0] = __hip_atomic_fetch_add(ctr, 1u, __ATOMIC_RELAXED, __HIP_MEMORY_SCOPE_AGENT);
    __syncthreads();
    int idx = (int)slot[0];
    while (idx < 512 + 64) {
        unsigned nxt = 0;
        if (tid == 0) nxt = __hip_atomic_fetch_add(ctr, 1u, __ATOMIC_RELAXED, __HIP_MEMORY_SCOPE_AGENT);
        if (idx >= 416 && idx < 480) compress_item(a, lds_g, idx - 416, tid, lane, wave);
        else diff_item(a, lds_g, idx < 416 ? idx : idx - 64, tid, lane, wave);
        if (tid == 0) slot[0] = nxt;
        asm volatile("s_waitcnt lgkmcnt(0)" ::: "memory"); __builtin_amdgcn_s_barrier(); asm volatile("" ::: "memory");
        idx = (int)slot[0];
    }
}

#define NSA_SETUP \
    using namespace att; \
    unsigned char* ws = a->ws; \
    int lane = lane_in; asm volatile("" : "+v"(lane)); int tid = tid_in; asm volatile("" : "+v"(tid)); \
    const int ci = 31 - (item & 31), g = (item >> 5) & 1, b = item >> 6; \
    const int r32 = lane & 31, hi = lane >> 5, hh = wave >> 1, hd = g * 4 + hh; \
    const int tl = 32 * (wave & 1) + r32, tq = ci * 64 + tl; \
    const size_t rowbase = (size_t)b * NT; \
    const bf16* QN = (const bf16*)(ws + WS_QN); const bf16* KV = (const bf16*)(ws + WS_KV); \
    const float* Gt = (const float*)(ws + WS_SMALL + SM_G) + (rowbase + tq) * 24 + hd * 3; \
    float* TMP = (float*)(ws + WS_NSATMP); bf16* ONSA = (bf16*)(ws + WS_ONSA); \
    LAS char* L = (LAS char*)lds_g; \
    LAS float* wscr = (LAS float*)(L + A_WSCR) + wave * 64; \
    const LAS float* tab = (const LAS float*)(L + A_BIAS) + hd * BT_STRIDE; \
    const float cb = tab[130]; \
    LAS float* scb = (LAS float*)(L + A_SC); \
    LAS unsigned* smask = (LAS unsigned*)(L + A_SMASK); LAS unsigned* un = (LAS unsigned*)(L + A_UN); \
    const int kofs = k_dma_off(wave, lane, 128), vofs = v_dma_off(wave, lane, 128); \
    const int vrb = v_rd_base(lane); \
    const unsigned obase0 = (unsigned)((rowbase + ci * 64 + 32 * (wave & 1) + 4 * hi) * 1024 + hd * 128 + r32); \
    (void)QN; (void)KV; (void)Gt; (void)TMP; (void)ONSA; (void)wscr; (void)tab; (void)cb; (void)scb; (void)smask; (void)un; (void)kofs; (void)vofs; (void)vrb; (void)obase0; (void)tq; (void)tl; (void)tid;
#define NSA_LOADQ bf16x8 qr[8]; { const bf16* qp = QN + ((size_t)hd * NM + rowbase + tq) * 128 + hi * 8; _Pragma("unroll") for (int d0 = 0; d0 < 8; ++d0) qr[d0] = *(const bf16x8*)(qp + d0 * 16); _Pragma("unroll") for (int d0 = 0; d0 < 8; ++d0) asm volatile("" : "+v"(qr[d0])); }
#define OROW(r) ((size_t)ob + (unsigned)((((r) & 3) + 8 * ((r) >> 2)) * 1024))
#define IMPP(h_, t_) ((LAS float*)(L + ((h_) < 2 ? A_IMPP : A_IMPP2)) + ((((h_) & 1) * 64 + (t_)) * 32))
__device__ __forceinline__ void nsa_b1(ArgP a, LAS unsigned char* lds_g, int item, int tid_in, int lane_in, int wave) {
    NSA_SETUP
    NSA_LOADQ
    f32x16 o[4]; (void)o;
    {
        const bf16* KC = (const bf16*)(ws + WS_SMALL + SM_KC) + (size_t)(b * 2 + g) * 128 * 128;
        const bf16* VC = (const bf16*)(ws + WS_SMALL + SM_VC) + (size_t)(b * 2 + g) * 128 * 128;
        if (tid < 64) smask[tid] = 0u; if (tid == 64) un[0] = 0u;
        { const int kc_ofs = k_dma_off(wave, lane, 128), vc_ofs = v_dma_off(wave, lane, 128);
#pragma unroll
          for (int tt = 0; tt < 2; ++tt) tile_dma<1>(KC + tt * 64 * 128, 128, VC + tt * 64 * 128, 128, kc_ofs, vc_ofs, L + A_KBUF + tt * SHM_K, L + A_VBUF + tt * 2 * SHM_V, wave); }
        __syncthreads();
        f32x16 pA0, pA1, pB0, pB1;
        qkt(pA0, pA1, L + A_KBUF, r32, hi, qr);
        qkt(pB0, pB1, L + A_KBUF + SHM_K, r32, hi, qr);
        const float NEG = -__builtin_inff();
        float pmax = NEG;
#define CMPX(P, coff) { _Pragma("unroll") for (int r = 0; r < 16; ++r) { const int d = tq - 31 - 16 * (crow(r, hi) + (coff)); const int ix = d > 127 ? 127 : (d < 0 ? 0 : d); float bv = tab[ix + 3]; asm volatile("" : "+v"(bv)); P[r] = d >= 0 ? P[r] + bv : NEG; pmax = fmaxf(pmax, P[r]); } }
        CMPX(pA0, 0) CMPX(pA1, 32) CMPX(pB0, 64) CMPX(pB1, 96)
#undef CMPX
        pmax = xhalf_max(pmax);
        const float mm = fmaxf(pmax, -1e30f);
        float ps = 0.f;
#pragma unroll
        for (int r = 0; r < 16; ++r) { pA0[r] = __builtin_amdgcn_exp2f(pA0[r] - mm); pA1[r] = __builtin_amdgcn_exp2f(pA1[r] - mm); pB0[r] = __builtin_amdgcn_exp2f(pB0[r] - mm); pB1[r] = __builtin_amdgcn_exp2f(pB1[r] - mm);
            ps += (pA0[r] + pA1[r]) + (pB0[r] + pB1[r]); }
        ps = xhalf_sum(ps);
        const float inv = ps > 0.f ? 1.0f / ps : 0.f;
#pragma unroll
        for (int r = 0; r < 16; ++r) { pA0[r] *= inv; pA1[r] *= inv; pB0[r] *= inv; pB1[r] *= inv; }
        {
            float dsum[16], p3[16];
#pragma unroll
            for (int q = 0; q < 4; ++q) {
                dsum[0 + q]  = 2.f * (pA0[4 * q] + pA0[4 * q + 1] + pA0[4 * q + 2]) + pA0[4 * q + 3]; p3[0 + q]  = pA0[4 * q + 3];
                dsum[4 + q]  = 2.f * (pA1[4 * q] + pA1[4 * q + 1] + pA1[4 * q + 2]) + pA1[4 * q + 3]; p3[4 + q]  = pA1[4 * q + 3];
                dsum[8 + q]  = 2.f * (pB0[4 * q] + pB0[4 * q + 1] + pB0[4 * q + 2]) + pB0[4 * q + 3]; p3[8 + q]  = pB0[4 * q + 3];
                dsum[12 + q] = 2.f * (pB1[4 * q] + pB1[4 * q + 1] + pB1[4 * q + 2]) + pB1[4 * q + 3]; p3[12 + q] = pB1[4 * q + 3];
            }
            LAS float* ip = IMPP(hh, tl);
#pragma unroll
            for (int G = 0; G < 16; ++G) {
                const float oth = __shfl_xor(p3[G], 32);
                const float othm = G > 0 ? __shfl_xor(p3[G > 0 ? G - 1 : 0], 32) : 0.f;
                ip[2 * G + hi] = dsum[G] + (hi ? oth : othm);
            }
        }
        bf16x8 pa0, pa1, pa2, pa3, pb0, pb1, pb2, pb3;
        pack_p(pA0, pA1, pa0, pa1, pa2, pa3); pack_p(pB0, pB1, pb0, pb1, pb2, pb3);
#pragma unroll
        for (int d = 0; d < 4; ++d) o[d] = f32x16{};
        pv_tile(o, (int)(unsigned)(uintptr_t)(L + A_VBUF) + vrb, pa0, pa1, pa2, pa3);
        pv_tile(o, (int)(unsigned)(uintptr_t)(L + A_VBUF + 2 * SHM_V) + vrb, pb0, pb1, pb2, pb3);
        scale_rows<4>(o, Gt[0], wscr, r32, hi);
        unsigned ob = obase0; asm volatile("" : "+v"(ob));
#pragma unroll
        for (int r = 0; r < 16; ++r) { float* rp = TMP + OROW(r);
#pragma unroll
            for (int d = 0; d < 4; ++d) rp[d * 32] = o[d][r]; }
    }
}
__device__ __forceinline__ void nsa_sel(ArgP a, LAS unsigned char* lds_g, int item, int tid_in, int lane_in, int wave) {
    NSA_SETUP
    f32x16 o[4]; (void)o;
    __syncthreads();
    {
        const int t = tid >> 3, jq = tid & 7;
        float sv[4];
#pragma unroll
        for (int e = 0; e < 4; ++e) { const int j = jq * 4 + e;
            const float imp = (IMPP(0, t)[j] + IMPP(1, t)[j]) + (IMPP(2, t)[j] + IMPP(3, t)[j]);
            const bool forced = (j == 0) || (j == ci) || (j == ci - 1);
            sv[e] = forced ? 1e4f : (j <= ci ? imp : -1e4f);
            scb[t * 33 + j] = sv[e]; }
        __syncthreads();
        unsigned bits = 0u;
#pragma unroll
        for (int e = 0; e < 4; ++e) { const int j = jq * 4 + e; int cnt = 0;
#pragma unroll 1
            for (int jj = 0; jj < 32; ++jj) { const float x = scb[t * 33 + jj]; cnt += (x > sv[e] || (x == sv[e] && jj < j)) ? 1 : 0; }
            if (cnt < 16) bits |= 1u << j; }
        __hip_atomic_fetch_or(&smask[t], bits, __ATOMIC_RELAXED, __HIP_MEMORY_SCOPE_WORKGROUP); __hip_atomic_fetch_or(&un[0], bits, __ATOMIC_RELAXED, __HIP_MEMORY_SCOPE_WORKGROUP);
        __syncthreads();
    }
}
__device__ __forceinline__ void nsa_b2(ArgP a, LAS unsigned char* lds_g, int item, int tid_in, int lane_in, int wave) {
    NSA_SETUP
    NSA_LOADQ
    f32x16 o[4]; (void)o;
    const unsigned mymask = smask[tl], umask = un[0];
    {
        const bf16* Kg = KV + ((size_t)(2 * 2 + g) * NM + rowbase) * 128;
        const bf16* Vg = KV + ((size_t)(3 * 2 + g) * NM + rowbase) * 128;
#pragma unroll
        for (int d = 0; d < 4; ++d) o[d] = f32x16{};
        float l = 0.f;
        const float CB = ((const LAS float*)(L + A_BIAS))[12 * BT_STRIDE + 2];
        unsigned rem = umask & (ci >= 31 ? 0xffffffffu : ((2u << ci) - 1u));
            int j = rem ? __builtin_ctz(rem) : -1;
        rem &= rem - 1;
        int j1 = rem ? __builtin_ctz(rem) : -1;
        tile_dma<1>(Kg + (size_t)j * 64 * 128, 128, Vg + (size_t)j * 64 * 128, 128, kofs, vofs, L + A_KBUF, L + A_VBUF, wave);
        if (j1 >= 0) { rem &= rem - 1; tile_dma<1>(Kg + (size_t)j1 * 64 * 128, 128, Vg + (size_t)j1 * 64 * 128, 128, kofs, vofs, L + A_KBUF + SHM_K, L + A_VBUF + 2 * SHM_V, wave); }
        int st = 0;
        while (j >= 0) {
            if (j1 >= 0) asm volatile("s_waitcnt vmcnt(4)" ::: "memory"); else asm volatile("s_waitcnt vmcnt(0)" ::: "memory");
            __builtin_amdgcn_s_barrier(); asm volatile("" ::: "memory");
            LAS char* Kb = L + A_KBUF + st * SHM_K; LAS char* Vb = L + A_VBUF + st * 2 * SHM_V;
            const int st2 = st == 0 ? 2 : st - 1;
            int j2 = -1;
            if (rem) { j2 = __builtin_ctz(rem); rem &= rem - 1;
                tile_dma<1>(Kg + (size_t)j2 * 64 * 128, 128, Vg + (size_t)j2 * 64 * 128, 128, kofs, vofs, L + A_KBUF + st2 * SHM_K, L + A_VBUF + st2 * 2 * SHM_V, wave); }
            f32x16 p0, p1;
            qkt(p0, p1, Kb, r32, hi, qr);
            const bool rowok = (mymask >> j) & 1u; float cbias = cb;
            if (j >= ci - 2) { xform<true>(p0, p1, tq - j * 64 - 4 * hi, 0x7fffffffu, rowok, cb, tab); cbias = 0.f; }
            bf16x8 pa0, pa1, pa2, pa3;
            sm_step_c(p0, p1, l, pa0, pa1, pa2, pa3, rowok ? cbias - CB : -__builtin_inff());
            pv_tile(o, (int)(unsigned)(uintptr_t)Vb + vrb, pa0, pa1, pa2, pa3);
            j = j1; j1 = j2; st = st == 2 ? 0 : st + 1;
        }
        __builtin_amdgcn_s_barrier();
        scale_rows<4>(o, l > 0.f ? Gt[1] / l : 0.f, wscr, r32, hi);
        { LAS float* wb = (LAS float*)(L + wave * OSTG_BYTES);
          ostage_write(o, wb, r32, hi);
          unsigned rb = (unsigned)((rowbase + ci * 64 + 32 * (wave & 1)) * 1024 + hd * 128); asm volatile("" : "+v"(rb));
#pragma unroll
          for (int i = 0; i < 16; ++i) { const int idx = i * 64 + lane; float* gp = TMP + ((size_t)rb + (unsigned)((idx >> 5) * 1024 + (idx & 31) * 4));
              *(f32x4*)gp = *(const f32x4*)gp + ostage_read(wb, i, lane); } }
        __syncthreads();
    }
}
__device__ __forceinline__ void nsa_b3(ArgP a, LAS unsigned char* lds_g, int item, int tid_in, int lane_in, int wave) {
    NSA_SETUP
    NSA_LOADQ
    f32x16 o[4]; (void)o;
    {
        const bf16* Kg = KV + ((size_t)(4 * 2 + g) * NM + rowbase) * 128;
        const bf16* Vg = KV + ((size_t)(5 * 2 + g) * NM + rowbase) * 128;
#pragma unroll
        for (int d = 0; d < 4; ++d) o[d] = f32x16{};
        float l = 0.f;
        const float CB = ((const LAS float*)(L + A_BIAS))[12 * BT_STRIDE + 3];
        const int j0 = ci >= 8 ? ci - 8 : 0, NTI = ci - j0 + 1;
        const int sr = tid >> 4, sc = (tid & 15) * 8, vst0 = v_st(sr, sc), vst1 = v_st(32 + sr, sc), kws = KSWZ(sr, sc * 2);
        Stage1 S;
        stage_load(S, Kg + (size_t)j0 * 64 * 128, Vg + (size_t)j0 * 64 * 128, sr, sc);
        stage_write(S, L + A_KBUF, L + A_VBUF, kws, vst0, vst1);
        if (NTI > 1) stage_load(S, Kg + (size_t)(j0 + 1) * 64 * 128, Vg + (size_t)(j0 + 1) * 64 * 128, sr, sc);
        for (int n = 0; n < NTI; ++n) {
            const int j = j0 + n;
            __syncthreads();
            LAS char* Kb = L + A_KBUF + (n & 1) * SHM_K; LAS char* Vb = L + A_VBUF + (n & 1) * 2 * SHM_V;
            if (n + 1 < NTI) { stage_write(S, L + A_KBUF + ((n + 1) & 1) * SHM_K, L + A_VBUF + ((n + 1) & 1) * 2 * SHM_V, kws, vst0, vst1);
                if (n + 2 < NTI) stage_load(S, Kg + (size_t)(j + 2) * 64 * 128, Vg + (size_t)(j + 2) * 64 * 128, sr, sc); }
            f32x16 p0, p1;
            qkt(p0, p1, Kb, r32, hi, qr);
            float cbias = cb;
            if (j >= ci - 2) { xform<true>(p0, p1, tq - j * 64 - 4 * hi, 512u, true, cb, tab); cbias = 0.f; }
            else if (j == ci - 8) { xform<false>(p0, p1, tq - j * 64 - 4 * hi, 512u, true, cb, tab); cbias = 0.f; }
            bf16x8 pa0, pa1, pa2, pa3;
            sm_step_c(p0, p1, l, pa0, pa1, pa2, pa3, cbias - CB);
            pv_tile(o, (int)(unsigned)(uintptr_t)Vb + vrb, pa0, pa1, pa2, pa3);
        }
        __syncthreads();
        scale_rows<4>(o, Gt[2] / l, wscr, r32, hi);
        { LAS float* wb = (LAS float*)(L + wave * OSTG_BYTES);
          ostage_write(o, wb, r32, hi);
          unsigned rb = (unsigned)((rowbase + ci * 64 + 32 * (wave & 1)) * 1024 + hd * 128); asm volatile("" : "+v"(rb));
#pragma unroll
          for (int i = 0; i < 16; ++i) { const int idx = i * 64 + lane; const size_t e = (size_t)rb + (unsigned)((idx >> 5) * 1024 + (idx & 31) * 4);
              const f32x4 v = *(const f32x4*)(TMP + e) + ostage_read(wb, i, lane);
              u32x2 w; w.x = cvtpk(v[0], v[1]); w.y = cvtpk(v[2], v[3]);
              *(u32x2*)(ONSA + e + (e & ~(size_t)1023)) = w; } }
        __syncthreads();
    }
}
__device__ __forceinline__ void nsa_item(ArgP a, LAS unsigned char* lds_g, int item, int tid, int lane, int wave) {
    nsa_b1(a, lds_g, item, tid, lane, wave);
    nsa_sel(a, lds_g, item, tid, lane, wave);
    nsa_b2(a, lds_g, item, tid, lane, wave);
    nsa_b3(a, lds_g, item, tid, lane, wave);
}
#undef NSA_SETUP
#undef NSA_LOADQ
#undef IMPP
#undef OROW
__device__ __forceinline__ void diff_finalize(ArgP a, int gw, int NGW, int lane) {
    unsigned char* ws = a->ws;
    const float lam = *(const float*)(ws + WS_SMALL + SM_LAM);
    const float* D0 = (const float*)(ws + WS_DTMP); const float* D1 = D0 + (size_t)NM * 1024;
    bf16* OD = (bf16*)(ws + WS_ONSA) + 1024;
    const f32x4 gn = *(const f32x4*)(a->in[16] + 4 * lane);
    for (int it = gw; it < NM * 4; it += NGW) {
        const size_t off = (size_t)it * 256 + 4 * lane;
        const f32x4 x0 = *(const f32x4*)(D0 + off), x1 = *(const f32x4*)(D1 + off);
        const f32x4 v = x0 - x1 * lam;
        const float ss = wave_sum((v[0] * v[0] + v[1] * v[1]) + (v[2] * v[2] + v[3] * v[3]));
        const float rs = rsqrtf(ss * (1.0f / 256.0f) + EPSF) * (1.0f - LAM_INIT);
        const f32x4 y = v * rs * gn;
        u32x2 w; w.x = pk2(y[0], y[1]); w.y = pk2(y[2], y[3]);
        *(u32x2*)(OD + off + ((size_t)(it >> 2) << 10)) = w;
    }
}

__device__ __forceinline__ void phase4(ArgP a, LAS unsigned char* lds, int tid, int lane, int wave) {
    LAS unsigned char* lds_g = lds;
    build_bias(a, (LAS float*)(lds_g + A_BIAS), tid);
    __syncthreads();
    for (int it = blockIdx.x; it < 256; it += gridDim.x) nsa_item(a, lds_g, (it & 7) * 32 + (it >> 3), tid, lane, wave);
    diff_finalize(a, blockIdx.x * NWAVES + wave, gridDim.x * NWAVES, lane);
    weights_b_queue(a, lds_g, wave, lane);
}
#ifndef ONE_LAUNCH
#define ONE_LAUNCH 0
#endif
constexpr int N_PHASES = 11;
__global__ void __launch_bounds__(NTHR, 2) mk_fwd(Args a) {
    extern __shared__ __attribute__((aligned(16))) unsigned char lds_raw[];
    LAS unsigned char* lds = (LAS unsigned char*)lds_raw;
    const int wave0 = __builtin_amdgcn_readfirstlane(threadIdx.x >> 6);
    const int lo = a.ph_lo, hi = a.ph_hi;
#define MK_TID(t_) int t_; { int w_ = wave0; asm volatile("" : "+s"(w_)); int l_; asm volatile("v_mbcnt_lo_u32_b32 %0, -1, 0\n\tv_mbcnt_hi_u32_b32 %0, -1, %0" : "=v"(l_)); t_ = w_ * 64 + l_; }
#if ONE_LAUNCH
    XcdBarrier bar;
    { MK_TID(t0_) if (t0_ < 16) ((volatile LAS unsigned*)(lds + MISC_OFF))[t0_] = 0u; __syncthreads();
      ArgP ap0 = argp(); bar = xcd_barrier_post((unsigned*)(ap0->ws + WS_SMALL + SM_BAR), (volatile LAS unsigned*)(lds + MISC_OFF), t0_);
    }
#define SEAM(k) do { if (lo <= (k) && (k) + 1 < hi) { MK_TID(ts_) xcd_barrier(bar, ts_); } } while (0)
#else
#define SEAM(k) do { } while (0)
#endif
#define IN(k) (lo <= (k) && (k) < hi)
#define PH_BEGIN ArgP ap = argp(); unsigned char* ws = ap->ws; float* mod = (float*)(ws + WS_SMALL + SM_MOD); (void)mod; \
    int wave = wave0; asm volatile("" : "+s"(wave)); int lane; asm volatile("v_mbcnt_lo_u32_b32 %0, -1, 0\n\tv_mbcnt_hi_u32_b32 %0, -1, %0" : "=v"(lane)); \
    const int tid = wave * 64 + lane, G = gridDim.x, gw = blockIdx.x * NWAVES + wave, NGW = G * NWAVES, gtid = blockIdx.x * NTHR + tid, NGT = G * NTHR; (void)gw; (void)NGW; (void)gtid; (void)NGT; (void)G;

    if (IN(0)) { PH_BEGIN p0_adaln(ap, lds, tid); p0_small(ap, tid); __syncthreads(); p0_weights(ap, lds, gw, NGW, wave, lane); }
    SEAM(0);
    if (IN(1)) { PH_BEGIN norm_rows(ap->in[0], ap->in[4], mod + 0, mod + 2048, (bf16*)(ws + WS_H), gw, NGW, lane); }
    SEAM(1);
    if (IN(2)) { PH_BEGIN
        pg8::Gemm g{(const bf16*)(ws + WS_H), (const bf16*)(ws + WS_WIN), NM, NIN, ND}; pg8::StaticOrder S; S.init(NM, NIN, G, (int)blockIdx.x);
        pg8::EpiInProj E{(bf16*)(ws + WS_QN), (bf16*)(ws + WS_KV), (bf16*)(ws + WS_DQ), (bf16*)(ws + WS_DK), (bf16*)(ws + WS_DV), (bf16*)(ws + WS_MG), (float*)(ws + WS_SMALL + SM_G),
                          ap->in[7], ap->in[8], ap->in[12], ap->in[13], (LAS float*)(lds + XL_OFF), QSCALE, EPSF};
        pg8::gemm_phase<pg8::EpiInProj, pg8::StaticOrder, true, true>(lds, g, S, E, tid, wave, lane);
    }
    SEAM(2);
    if (IN(3)) { PH_BEGIN phase3(ap, lds, tid, lane, wave); }
    SEAM(3);
    if (IN(4)) { PH_BEGIN phase4(ap, lds, tid, lane, wave); }
    SEAM(4);
    if (IN(5)) { PH_BEGIN
        pg8::Gemm g{(const bf16*)(ws + WS_ONSA), (const bf16*)(ws + WS_WNSA), NM, ND, 2048}; pg8::StaticOrder S; S.init(NM, ND, G, (int)blockIdx.x);
        pg8::EpiMix E{(const bf16*)(ws + WS_MG), (bf16*)(ws + WS_MIX)};
        pg8::gemm_phase<pg8::EpiMix, pg8::StaticOrder, true, true>(lds, g, S, E, tid, wave, lane);
    }
    SEAM(5);
    if (IN(6)) { PH_BEGIN
        pg8::Gemm g{(const bf16*)(ws + WS_MIX), (const bf16*)(ws + WS_WO), NM, ND, ND}; pg8::StaticOrder S; S.init(NM, ND, G, (int)blockIdx.x);
        if (G == 256) {
            pg8::EpiResidNorm E{ap->in[0], mod + 4096, 12288, ap->out, (bf16*)(ws + WS_H), ap->in[5], mod + 8192, mod + 6144,
                                (unsigned*)(ws + WS_SMALL + SM_SLOTS), (unsigned*)(ws + WS_SMALL + SM_PCNT), EPSF};
            pg8::gemm_phase<pg8::EpiResidNorm, pg8::StaticOrder, false, true>(lds, g, S, E, tid, wave, lane);
        } else {
            pg8::EpiResid E{ap->in[0], mod + 4096, 12288, ap->out};
            pg8::gemm_phase<pg8::EpiResid, pg8::StaticOrder, true, true>(lds, g, S, E, tid, wave, lane);
        }
    }
    SEAM(6);
    if (IN(7) && gridDim.x != 256) { PH_BEGIN norm_rows(ap->out, ap->in[5], mod + 6144, mod + 8192, (bf16*)(ws + WS_H), gw, NGW, lane); }
    if (gridDim.x != 256) SEAM(7);
    if (IN(8)) { PH_BEGIN
        pg8::Gemm g{(const bf16*)(ws + WS_H), (const bf16*)(ws + WS_WUP), NM, NUP, ND}; pg8::StaticOrder S; S.init(NM, NUP, G, (int)blockIdx.x);
        pg8::EpiUpAct E{(bf16*)(ws + WS_ACT2), ap->in[21], ap->in[22], (float*)(ws + WS_HF), (float*)(ws + WS_HL), (LAS float*)(lds + XL_OFF), NF, NUP};
        pg8::gemm_phase<pg8::EpiUpAct, pg8::StaticOrder, true, true>(lds, g, S, E, tid, wave, lane);
    }
    SEAM(8);
    if (IN(10)) { PH_BEGIN
        pg8::Gemm g{(const bf16*)(ws + WS_ACT2), (const bf16*)(ws + WS_WDOWN), NM, ND, NF}; pg8::StaticOrder S; S.init(NM, ND, G, (int)blockIdx.x);
        { pg8::Unit u0; for (int i = 0; S.next(i, u0); ++i) act_fixup((const float*)(ws + WS_HF), (const float*)(ws + WS_HL), ap->in[21], ap->in[22], (bf16*)(ws + WS_ACT2), u0.pm, tid);
          asm volatile("s_waitcnt vmcnt(0)" ::: "memory"); __syncthreads(); }
        pg8::EpiResid E{ap->out, mod + 10240, 12288, ap->out};
        pg8::gemm_phase<pg8::EpiResid, pg8::StaticOrder, true, true>(lds, g, S, E, tid, wave, lane);
    }
#undef IN
#undef PH_BEGIN
#undef SEAM
}

extern "C" void kernel_launch(void* const* d_in, const int* in_sizes, int n_in, void* d_out, int out_size, void* d_ws, size_t ws_size, hipStream_t stream) {
    static int grid = 0;
    if (grid == 0) {
        if (n_in != 25 || out_size != NM * ND || ws_size < WS_END) { fprintf(stderr, "kernel_launch: unexpected shapes (n_in %d out %d ws %zu)\n", n_in, out_size, ws_size); grid = -1; return; }
        int dev = 0, cus = 0, per_cu = 0;
        (void)hipGetDevice(&dev); (void)hipDeviceGetAttribute(&cus, hipDeviceAttributeMultiprocessorCount, dev);
        if (hipFuncSetAttribute((const void*)mk_fwd, hipFuncAttributeMaxDynamicSharedMemorySize, LDS_BYTES) != hipSuccess) { fprintf(stderr, "kernel_launch: hipFuncSetAttribute failed\n"); grid = -1; return; }
        if (hipOccupancyMaxActiveBlocksPerMultiprocessor(&per_cu, (const void*)mk_fwd, NTHR, LDS_BYTES) != hipSuccess || per_cu < 1) { fprintf(stderr, "kernel_launch: occupancy query says %d\n", per_cu); per_cu = 1; }
        (void)hipGetLastError();
        grid = cus < 256 ? cus : 256;
    }
    if (grid < 0) return;
    Args a{};
    for (int i = 0; i < 25; ++i) a.in[i] = (const float*)d_in[i];
    a.out = (float*)d_out; a.ws = (unsigned char*)d_ws;
    (void)hipMemsetAsync((char*)d_ws + WS_SMALL + SM_BAR, 0, SM_BAR_BYTES, stream);
#if ONE_LAUNCH
    a.ph_lo = 0; a.ph_hi = N_PHASES;
    void* args[] = {&a};
    hipError_t e = hipLaunchCooperativeKernel((const void*)mk_fwd, dim3(grid), dim3(NTHR), args, LDS_BYTES, stream);
    if (e != hipSuccess) fprintf(stderr, "cooperative launch failed: %s (grid %d)\n", hipGetErrorString(e), grid);
#else
    for (int p = 0; p < N_PHASES; ++p) {
        if (p == 9) continue;
        a.ph_lo = p; a.ph_hi = p + 1;
        hipLaunchKernelGGL(mk_fwd, dim3(grid), dim3(NTHR), LDS_BYTES, stream, a);
    }
#endif
}
```

```cpp
#include <hip/hip_runtime.h>
#include <hip/hip_cooperative_groups.h>
#include <cstdio>
#include <cstdint>
namespace cg = cooperative_groups;
#define ONE_LAUNCH 1
namespace pg8 {
#define PG8_LAS __attribute__((address_space(3)))
typedef unsigned short bf16_t;
typedef short bf16x8 __attribute__((ext_vector_type(8)));
typedef float f32x4 __attribute__((ext_vector_type(4)));
typedef unsigned u32x4 __attribute__((ext_vector_type(4)));
constexpr int BM = 256, BK = 64, HALF = 128, HTB = HALF * BK * 2  , STAGE_BYTES = 8 * HTB, NXCD = 8, WGM = 8;

__host__ __device__ __forceinline__ int lds_byte(int r, int c) { const int st = (r >> 4) * 2 + (c >> 5), rr = r & 15, cc = c & 31, ob = rr * 64 + cc * 2; return st * 1024 + (ob ^ (((ob >> 9) & 1) << 5)); }
__host__ __device__ __forceinline__ void stage_rc(int b, int& R, int& C) { const int st = b / 1024, sb = b % 1024, swz = sb ^ (((sb >> 9) & 1) << 5); R = (st >> 1) * 16 + swz / 64; C = (st & 1) * 32 + (swz % 64) / 2; }
__host__ __device__ __forceinline__ int perm32(int rho) { const int n = rho >> 4, i = rho & 15; return 8 * (i >> 2) + 4 * n + (i & 3); }

struct Unit { int pm, pn; };
struct Gemm { const bf16_t* A; const bf16_t* Bt; int M, N, K; };

struct StaticOrder {
    int nM, nN, nwg, G, c;
    __host__ __device__ void init(int M, int N, int G_, int c_) { nM = M / BM; nN = N / BM; nwg = nM * nN; G = G_; c = c_; }
    __host__ __device__ bool next(int i, Unit& u) const {
        const long L = (long)i * G + c; if (L >= nwg) return false;
        int wgid = (int)L; { const int q = nwg / NXCD, r = nwg % NXCD, xcd = wgid % NXCD, off = wgid / NXCD; wgid = (xcd < r ? xcd * (q + 1) : r * (q + 1) + (xcd - r) * q) + off; }
        const int nig = WGM * nN, gid = wgid / nig, fm = gid * WGM, gsz = (nM - fm) < WGM ? (nM - fm) : WGM;
        u.pm = fm + ((wgid % nig) % gsz); u.pn = (wgid % nig) / gsz; return true;
    }
    __device__ __forceinline__ void a_ready(const Unit&) const {}
    __device__ __forceinline__ void done(const Unit&) const {}
};
__device__ __forceinline__ unsigned cvt_pk_bf16(float lo, float hi) { unsigned r; asm volatile("v_cvt_pk_bf16_f32 %0, %1, %2" : "=v"(r) : "v"(lo), "v"(hi)); return r; }
typedef unsigned u32x4 __attribute__((ext_vector_type(4)));
__device__ __forceinline__ void st8_bf16(bf16_t* p, f32x4 v0, f32x4 v1) {
    u32x4 w; w.x = cvt_pk_bf16(v0[0], v0[1]); w.y = cvt_pk_bf16(v0[2], v0[3]); w.z = cvt_pk_bf16(v1[0], v1[1]); w.w = cvt_pk_bf16(v1[2], v1[3]);
    *(u32x4*)p = w;
}
__device__ __forceinline__ void ld8_bf16(const bf16_t* p, f32x4& v0, f32x4& v1) {
    const u32x4 w = *(const u32x4*)p;
    v0[0] = __uint_as_float(w.x << 16); v0[1] = __uint_as_float(w.x & 0xffff0000u); v0[2] = __uint_as_float(w.y << 16); v0[3] = __uint_as_float(w.y & 0xffff0000u);
    v1[0] = __uint_as_float(w.z << 16); v1[1] = __uint_as_float(w.z & 0xffff0000u); v1[2] = __uint_as_float(w.w << 16); v1[3] = __uint_as_float(w.w & 0xffff0000u);
}
__device__ __forceinline__ float sigmoidf_(float x) { return 1.0f / (1.0f + __expf(-x)); }

struct EpiInProj {
    static constexpr bool PERM = true, AFTER_DRAIN = false, HAS_MID = false;
    bf16_t *QN, *KV, *DQ, *DK, *DV, *MG; float* G;
    const float *qgain, *kgain, *dqgain, *dkgain;
    PG8_LAS float* xl;
    float qscale, eps;
    __device__ __forceinline__ void operator()(const f32x4 (&acc)[2][2][4][2], const Unit& u, int wr, int wc, int fr, int fq) const {
        const int pn = u.pn, row0 = u.pm * BM + wr * 64 + fr, cw = wc * 32 + 8 * fq;
        int mode; bf16_t* dst; int ldc, cbase, bjs; const float* gain = nullptr; float sc = 1.f;
        constexpr int SL = 8192 * 128;
        if (pn < 4)        { mode = 0; dst = QN + (size_t)(pn * 2) * SL; ldc = 128; cbase = 0; bjs = SL; gain = qgain; sc = qscale; }
        else if (pn < 10)  { const int br = (pn - 4) >> 1, kvsel = (pn - 4) & 1; dst = KV + (size_t)((pn - 4) * 2) * SL; ldc = 128; cbase = 0; bjs = SL;
                             if (kvsel == 0 && br > 0) { mode = 0; gain = kgain + br * 128; } else mode = 1; }
        else if (pn < 14)  { mode = 0; dst = DQ + (size_t)((pn - 10) * 2) * SL; ldc = 128; cbase = 0; bjs = SL; gain = dqgain; sc = qscale; }
        else if (pn < 18)  { mode = 0; dst = DK + (size_t)((pn - 14) * 2) * SL; ldc = 128; cbase = 0; bjs = SL; gain = dkgain; }
        else if (pn < 22)  { mode = 1; dst = DV + (size_t)(pn - 18) * (2 * SL); ldc = 256; cbase = 0; bjs = HALF; }
        else if (pn < 38)  { mode = 2; dst = MG; ldc = 4096; cbase = (pn - 22) * 256; bjs = HALF; }
        else               { mode = 3; dst = nullptr; ldc = 0; cbase = 0; bjs = 0; }
        if (mode == 0) {
#pragma unroll
            for (int ai = 0; ai < 2; ++ai)
#pragma unroll
                for (int m = 0; m < 4; ++m)
#pragma unroll
                    for (int bj = 0; bj < 2; ++bj) {
                        const f32x4 a = acc[ai][bj][m][0], b = acc[ai][bj][m][1];
                        float s = (a[0] * a[0] + a[1] * a[1]) + (a[2] * a[2] + a[3] * a[3]) + (b[0] * b[0] + b[1] * b[1]) + (b[2] * b[2] + b[3] * b[3]);
                        s += __shfl_xor(s, 16); s += __shfl_xor(s, 32);
                        if (fq == 0) xl[(ai * HALF + wr * 64 + m * 16 + fr) * 8 + bj * 4 + wc] = s;
                    }
            asm volatile("s_waitcnt lgkmcnt(0)" ::: "memory"); __builtin_amdgcn_s_barrier(); asm volatile("" ::: "memory");
            f32x4 g0 = *(const f32x4*)(gain + cw), g1 = *(const f32x4*)(gain + cw + 4);
            g0 = g0 * sc; g1 = g1 * sc;
#pragma unroll
            for (int ai = 0; ai < 2; ++ai)
#pragma unroll
                for (int m = 0; m < 4; ++m) { const int rl = ai * HALF + wr * 64 + m * 16 + fr; bf16_t* rowp = dst + (size_t)(u.pm * BM + rl) * ldc + cbase + cw;
#pragma unroll
                    for (int bj = 0; bj < 2; ++bj) {
                        const f32x4 ps = *(const PG8_LAS f32x4*)(xl + rl * 8 + bj * 4);
                        const float rs = rsqrtf(((ps[0] + ps[1]) + (ps[2] + ps[3])) * (1.0f / 128.0f) + eps);
                        st8_bf16(rowp + (size_t)bj * bjs, acc[ai][bj][m][0] * rs * g0, acc[ai][bj][m][1] * rs * g1); } }
        } else if (mode == 1) {
#pragma unroll
            for (int ai = 0; ai < 2; ++ai)
#pragma unroll
                for (int m = 0; m < 4; ++m) { bf16_t* rowp = dst + (size_t)(row0 + ai * HALF + m * 16) * ldc + cbase + cw;
#pragma unroll
                    for (int bj = 0; bj < 2; ++bj) st8_bf16(rowp + (size_t)bj * bjs, acc[ai][bj][m][0], acc[ai][bj][m][1]); }
        } else if (mode == 2) {
#pragma unroll
            for (int ai = 0; ai < 2; ++ai)
#pragma unroll
                for (int m = 0; m < 4; ++m) { bf16_t* rowp = dst + (size_t)(row0 + ai * HALF + m * 16) * ldc + cbase + cw;
#pragma unroll
                    for (int bj = 0; bj < 2; ++bj) { f32x4 a = acc[ai][bj][m][0], b = acc[ai][bj][m][1];
#pragma unroll
                        for (int e = 0; e < 4; ++e) { a[e] = sigmoidf_(a[e]); b[e] = sigmoidf_(b[e]); }
                        st8_bf16(rowp + (size_t)bj * bjs, a, b); } }
        } else {
            if (wc == 0 && fq < 3) {
#pragma unroll
                for (int ai = 0; ai < 2; ++ai)
#pragma unroll
                    for (int m = 0; m < 4; ++m) { float* gp = G + (size_t)(row0 + ai * HALF + m * 16) * 24 + 8 * fq;
                        f32x4 a = acc[ai][0][m][0], b = acc[ai][0][m][1];
#pragma unroll
                        for (int e = 0; e < 4; ++e) { a[e] = sigmoidf_(a[e]); b[e] = sigmoidf_(b[e]); }
                        *(f32x4*)gp = a; *(f32x4*)(gp + 4) = b; }
            }
        }
    }
};

struct EpiMix {
    static constexpr bool PERM = true, AFTER_DRAIN = false, HAS_MID = true;
    const bf16_t* MG; bf16_t* MIX;
    __device__ __forceinline__ void mid(f32x4 (&acc)[2][2][4][2], const Unit& u, int wr, int wc, int fr, int fq) const {
        int c0 = wc * 32 + 8 * fq, row0 = u.pm * BM + wr * 64 + fr; asm volatile("" : "+v"(c0), "+v"(row0));
        const int col0 = u.pn * BM + c0;
#pragma unroll
        for (int ai = 0; ai < 2; ++ai)
#pragma unroll
            for (int m = 0; m < 4; ++m) { const size_t row = (size_t)(row0 + ai * HALF + m * 16);
#pragma unroll
                for (int bj = 0; bj < 2; ++bj) { f32x4 g0, g1, h0, h1; ld8_bf16(MG + row * 4096 + col0 + bj * HALF, g0, g1); ld8_bf16(MG + row * 4096 + 2048 + col0 + bj * HALF, h0, h1);
#pragma unroll
                    for (int e = 0; e < 4; ++e) { acc[ai][bj][m][0][e] *= g0[e] * __builtin_amdgcn_rcpf(fmaxf(h0[e], 1e-30f)); acc[ai][bj][m][1][e] *= g1[e] * __builtin_amdgcn_rcpf(fmaxf(h1[e], 1e-30f)); }
                    __builtin_amdgcn_sched_barrier(0); } }
    }
    __device__ __forceinline__ void operator()(const f32x4 (&acc)[2][2][4][2], const Unit& u, int wr, int wc, int fr, int fq) const {
        int row0 = u.pm * BM + wr * 64 + fr, col0 = u.pn * BM + wc * 32 + 8 * fq; asm volatile("" : "+v"(row0), "+v"(col0));
#pragma unroll
        for (int ai = 0; ai < 2; ++ai)
#pragma unroll
            for (int m = 0; m < 4; ++m) { const size_t row = (size_t)(row0 + ai * HALF + m * 16);
#pragma unroll
                for (int bj = 0; bj < 2; ++bj) { f32x4 h0, h1; ld8_bf16(MG + row * 4096 + 2048 + col0 + bj * HALF, h0, h1);
                    st8_bf16(MIX + row * 2048 + col0 + bj * HALF, h0 * acc[ai][bj][m][0], h1 * acc[ai][bj][m][1]); } }
    }
};
struct EpiResid {
    static constexpr bool PERM = true, AFTER_DRAIN = false, HAS_MID = false;
    const float* base; const float* gate; int gstride; float* out;
    __device__ __forceinline__ void operator()(const f32x4 (&acc)[2][2][4][2], const Unit& u, int wr, int wc, int fr, int fq) const {
        const int row0 = u.pm * BM + wr * 64 + fr, col0 = u.pn * BM + wc * 32 + 8 * fq;
        const float* gp = gate + (size_t)(u.pm >> 3) * gstride + col0;
        f32x4 gv[2][2];
#pragma unroll
        for (int bj = 0; bj < 2; ++bj) { gv[bj][0] = *(const f32x4*)(gp + bj * HALF); gv[bj][1] = *(const f32x4*)(gp + bj * HALF + 4); }
#pragma unroll
        for (int ai = 0; ai < 2; ++ai)
#pragma unroll
            for (int m = 0; m < 4; ++m) { const size_t off = (size_t)(row0 + ai * HALF + m * 16) * 2048 + col0;
#pragma unroll
                for (int bj = 0; bj < 2; ++bj) {
                    const f32x4 x0 = *(const f32x4*)(base + off + bj * HALF), x1 = *(const f32x4*)(base + off + bj * HALF + 4);
                    *(f32x4*)(out + off + bj * HALF) = x0 + gv[bj][0] * acc[ai][bj][m][0];
                    *(f32x4*)(out + off + bj * HALF + 4) = x1 + gv[bj][1] * acc[ai][bj][m][1]; } }
    }
};

__device__ __forceinline__ float dpp_ror(float v, const int n) { return n == 1 ? __int_as_float(__builtin_amdgcn_update_dpp(0, __float_as_int(v), 0x121, 0xf, 0xf, false)) : __int_as_float(__builtin_amdgcn_update_dpp(0, __float_as_int(v), 0x122, 0xf, 0xf, false)); }
__device__ __forceinline__ float silu_fast(float x) { return x * __builtin_amdgcn_rcpf(1.0f + __builtin_amdgcn_exp2f(-1.4426950408889634f * x)); }
struct EpiUpAct {
    static constexpr bool PERM = true, AFTER_DRAIN = false, HAS_MID = false;
    bf16_t* ACT; const float* cw; const float* cb; float* HF; float* HL; PG8_LAS float* xb; int NFc, NUPc;
    __device__ __forceinline__ void operator()(const f32x4 (&acc)[2][2][4][2], const Unit& u, int wr, int wc, int fr, int fq) const {
        int cl = wc * 32 + 8 * fq; asm volatile("" : "+v"(cl));
        const int colt = u.pn * BM;
#pragma unroll
        for (int ai = 0; ai < 2; ++ai)
#pragma unroll
            for (int bj = 0; bj < 2; ++bj)
                if (fr >= 14) { PG8_LAS float* p = xb + ((ai * 2 + wr) * 2 + (fr - 14)) * 256 + bj * HALF + cl; *(PG8_LAS f32x4*)p = acc[ai][bj][3][0]; *(PG8_LAS f32x4*)(p + 4) = acc[ai][bj][3][1]; }
        if (wr == 0 && fr < 2) {
#pragma unroll
            for (int bj = 0; bj < 2; ++bj) { float* p = HF + (size_t)(u.pm * 2 + fr) * NUPc + colt + bj * HALF + cl; *(f32x4*)p = acc[0][bj][0][0]; *(f32x4*)(p + 4) = acc[0][bj][0][1]; } }
        if (wr == 1 && fr >= 14) {
#pragma unroll
            for (int bj = 0; bj < 2; ++bj) { float* p = HL + (size_t)(u.pm * 2 + fr - 14) * NUPc + colt + bj * HALF + cl; *(f32x4*)p = acc[1][bj][3][0]; *(f32x4*)(p + 4) = acc[1][bj][3][1]; } }
        asm volatile("s_waitcnt lgkmcnt(0)" ::: "memory"); __builtin_amdgcn_s_barrier(); asm volatile("" ::: "memory");
        const bool bstart = (u.pm & 7) == 0;
#pragma unroll
        for (int ai = 0; ai < 2; ++ai) {
            const int band = ai * 2 + wr;
            unsigned pk0[4][2];
#pragma unroll
            for (int n = 0; n < 2; ++n) {
                f32x4 cva[4];
#pragma unroll
                for (int bj = 0; bj < 2; ++bj) {
                    const int ch = (bj ? NFc : 0) + u.pn * HALF + cl + 4 * n;
                    const f32x4 w0 = *(const f32x4*)(cw + ch), w1 = *(const f32x4*)(cw + NUPc + ch), w2 = *(const f32x4*)(cw + 2 * NUPc + ch), bb = *(const f32x4*)(cb + ch);
                    f32x4 B0 = {0.f, 0.f, 0.f, 0.f}, B1 = B0;
                    if (band > 0) { const PG8_LAS float* p = xb + ((band - 1) * 2) * 256 + bj * HALF + cl + 4 * n; B0 = *(const PG8_LAS f32x4*)p; B1 = *(const PG8_LAS f32x4*)(p + 256); }
                    f32x4 P1 = B1, P2;
#pragma unroll
                    for (int e = 0; e < 4; ++e) P2[e] = fr == 0 ? B0[e] : B1[e];
#pragma unroll
                    for (int m = 0; m < 4; ++m) {
                        const f32x4 X = acc[ai][bj][m][n]; f32x4 R1, R2, c;
#pragma unroll
                        for (int e = 0; e < 4; ++e) { R1[e] = dpp_ror(X[e], 1); R2[e] = dpp_ror(X[e], 2);
                            const float u1 = fr == 0 ? P1[e] : R1[e], u2 = fr < 2 ? P2[e] : R2[e];
                            c[e] = bb[e] + w0[e] * u2 + w1[e] * u1 + w2[e] * X[e]; }
                        P1 = R1; P2 = R2;
                        if (bj == 0) cva[m] = c;
                        else {
                            f32x4 a;
#pragma unroll
                            for (int e = 0; e < 4; ++e) a[e] = silu_fast(cva[m][e]) * c[e];
                            if (n == 0) { pk0[m][0] = cvt_pk_bf16(a[0], a[1]); pk0[m][1] = cvt_pk_bf16(a[2], a[3]); }
                            else { u32x4 w; w.x = pk0[m][0]; w.y = pk0[m][1]; w.z = cvt_pk_bf16(a[0], a[1]); w.w = cvt_pk_bf16(a[2], a[3]);
                                const bool skip = band == 0 && m == 0 && fr < 2 && !bstart;
                                if (!skip) *(u32x4*)(ACT + (size_t)(u.pm * BM + ai * HALF + wr * 64 + m * 16 + fr) * NFc + u.pn * HALF + cl) = w; }
                        }
                    }
                    __builtin_amdgcn_sched_barrier(0);
                }
            }
        }
    }
};

struct EpiResidNorm {
    static constexpr bool PERM = true, AFTER_DRAIN = true, HAS_MID = false;
    const float* base; const float* gate; int gstride; float* out;
    bf16_t* H; const float* gain; const float* sc; const float* sh;
    unsigned* slots; unsigned* cnt; float eps;
    __device__ __forceinline__ void operator()(const f32x4 (&)[2][2][4][2], const Unit&, int, int, int, int) const {}
    __device__ __forceinline__ void fused(f32x4 (&acc)[2][2][4][2], const Unit& u, int wr, int wc, int fr, int fq, PG8_LAS unsigned char* lds, int wid, int lane) const {
        PG8_LAS float* P = (PG8_LAS float*)lds;
        PG8_LAS float* S = (PG8_LAS float*)(lds + 4096);
        const int row0 = u.pm * BM + wr * 64 + fr, col0 = u.pn * BM + wc * 32 + 8 * fq, bidx = u.pm >> 3;
        { const float* gp = gate + (size_t)bidx * gstride + col0;
          f32x4 gv[2][2];
#pragma unroll
          for (int bj = 0; bj < 2; ++bj) { gv[bj][0] = *(const f32x4*)(gp + bj * HALF); gv[bj][1] = *(const f32x4*)(gp + bj * HALF + 4); }
#pragma unroll
          for (int ai = 0; ai < 2; ++ai)
#pragma unroll
            for (int m = 0; m < 4; ++m) { const size_t off = (size_t)(row0 + ai * HALF + m * 16) * 2048 + col0; float s = 0.f;
#pragma unroll
                for (int bj = 0; bj < 2; ++bj) {
                    const f32x4 x0 = *(const f32x4*)(base + off + bj * HALF), x1 = *(const f32x4*)(base + off + bj * HALF + 4);
                    const f32x4 v0 = x0 + gv[bj][0] * acc[ai][bj][m][0], v1 = x1 + gv[bj][1] * acc[ai][bj][m][1];
                    *(f32x4*)(out + off + bj * HALF) = v0; *(f32x4*)(out + off + bj * HALF + 4) = v1;
                    acc[ai][bj][m][0] = v0; acc[ai][bj][m][1] = v1; asm volatile("" : "+v"(acc[ai][bj][m][0]), "+v"(acc[ai][bj][m][1]));
                    s += (v0[0] * v0[0] + v0[1] * v0[1]) + (v0[2] * v0[2] + v0[3] * v0[3]) + (v1[0] * v1[0] + v1[1] * v1[1]) + (v1[2] * v1[2] + v1[3] * v1[3]); }
                s += __shfl_xor(s, 16); s += __shfl_xor(s, 32);
                if (fq == 0) P[(ai * HALF + wr * 64 + m * 16 + fr) * 4 + wc] = s; } }
        asm volatile("s_waitcnt lgkmcnt(0)" ::: "memory"); __builtin_amdgcn_s_barrier(); asm volatile("" ::: "memory");
        const int prow = wid * 32 + (lane & 31);
        if (lane < 32) { const f32x4 p = *(const PG8_LAS f32x4*)(P + prow * 4);
            __hip_atomic_store(slots + (size_t)(u.pm * BM + prow) * 8 + u.pn, __float_as_uint((p[0] + p[1]) + (p[2] + p[3])), __ATOMIC_RELAXED, __HIP_MEMORY_SCOPE_AGENT); }
        asm volatile("s_waitcnt vmcnt(0)" ::: "memory");
        if (lane == 0) __hip_atomic_fetch_add(cnt + 64 * u.pm, 1u, __ATOMIC_RELAXED, __HIP_MEMORY_SCOPE_AGENT);
        if (wid == 0) { unsigned spins = 0;
            while ((unsigned)__builtin_amdgcn_readfirstlane((int)__hip_atomic_load(cnt + 64 * u.pm, __ATOMIC_RELAXED, __HIP_MEMORY_SCOPE_AGENT)) < 64u && ++spins < (1u << 22)) __builtin_amdgcn_s_sleep(2);
            __builtin_amdgcn_fence(__ATOMIC_ACQUIRE, "agent"); }
        asm volatile("s_waitcnt vmcnt(0) lgkmcnt(0)" ::: "memory"); __builtin_amdgcn_s_barrier(); asm volatile("" ::: "memory");
        if (lane < 32) { const unsigned* sp = slots + (size_t)(u.pm * BM + prow) * 8; float t = 0.f;
#pragma unroll
            for (int k = 0; k < 8; ++k) t += __uint_as_float(__hip_atomic_load(sp + k, __ATOMIC_RELAXED, __HIP_MEMORY_SCOPE_AGENT));
            S[prow] = rsqrtf(t * (1.0f / 2048.0f) + eps); }
        asm volatile("s_waitcnt lgkmcnt(0)" ::: "memory"); __builtin_amdgcn_s_barrier(); asm volatile("" ::: "memory");
#pragma unroll
        for (int bj = 0; bj < 2; ++bj) {
            const int c = col0 + bj * HALF;
            f32x4 g0 = *(const f32x4*)(gain + c), g1 = *(const f32x4*)(gain + c + 4);
            const f32x4 a0 = *(const f32x4*)(sc + (size_t)bidx * gstride + c), a1 = *(const f32x4*)(sc + (size_t)bidx * gstride + c + 4);
            const f32x4 h0 = *(const f32x4*)(sh + (size_t)bidx * gstride + c), h1 = *(const f32x4*)(sh + (size_t)bidx * gstride + c + 4);
            g0 = g0 * (a0 + 1.0f); g1 = g1 * (a1 + 1.0f);
#pragma unroll
            for (int ai = 0; ai < 2; ++ai)
#pragma unroll
                for (int m = 0; m < 4; ++m) { const int rl = ai * HALF + wr * 64 + m * 16 + fr; const float rs = S[rl];
                    st8_bf16(H + (size_t)(u.pm * BM + rl) * 2048 + c, acc[ai][bj][m][0] * rs * g0 + h0, acc[ai][bj][m][1] * rs * g1 + h1); }
        }
    }
};

template <class Epi, class Sched, bool ALIGN_EPI = false, bool SP2 = false>
__device__ __forceinline__ void gemm_phase(PG8_LAS unsigned char* lds, const Gemm g, const Sched& S, const Epi& E, const int tid, const int wid, const int lane) {
    const int wr = wid >> 2, wc = wid & 3, fr = lane & 15, fq = lane >> 4;
    const int K = g.K, nt = K / BK;
    unsigned voffA[2], voffB[2];
#pragma unroll
    for (int i = 0; i < 2; ++i) { int R, C; stage_rc(tid * 16 + i * 8192, R, C); const int Rb = Epi::PERM ? ((R & ~31) + perm32(R & 31)) : R;
        voffA[i] = (unsigned)(R * K + C) * 2u; voffB[i] = (unsigned)(Rb * K + C) * 2u; }
    const size_t kstep = (size_t)(BK * 2);
    const size_t hstep = (size_t)HALF * K * 2;
    const size_t tstep = 2 * hstep;
    const unsigned ldsw = (unsigned)wid * 1024u;
    const int aoff = lds_byte(wr * 64 + fr, fq * 8), boff = lds_byte(wc * 32 + fr, fq * 8);
#define PG8_SA(b, h) (((b) * 2 + (h)) * HTB)
#define PG8_SB(b, h) ((4 + (b) * 2 + (h)) * HTB)
#define PG8_STAGE(bufoff, gbase, voff) do { _Pragma("unroll") for (int _i = 0; _i < 2; ++_i) \
        __builtin_amdgcn_global_load_lds((const unsigned*)((const char*)(gbase) + (voff)[_i]), (PG8_LAS unsigned*)(lds + (bufoff) + ldsw + _i * 8192), 16, 0, 0); } while (0)
#define PG8_LDA(dst, b, h) do { _Pragma("unroll") for (int m = 0; m < 4; ++m) _Pragma("unroll") for (int k = 0; k < 2; ++k) dst[m][k] = *(const PG8_LAS bf16x8*)(lds + PG8_SA(b, h) + aoff + m * 2048 + k * 1024); } while (0)
#define PG8_LDB(dst, b, h) do { _Pragma("unroll") for (int n = 0; n < 2; ++n) _Pragma("unroll") for (int k = 0; k < 2; ++k) dst[n][k] = *(const PG8_LAS bf16x8*)(lds + PG8_SB(b, h) + boff + n * 2048 + k * 1024); } while (0)
#define PG8_MMA(ai, bj, At, Bt) do { __builtin_amdgcn_s_setprio(1); _Pragma("unroll") for (int m = 0; m < 4; ++m) _Pragma("unroll") for (int n = 0; n < 2; ++n) _Pragma("unroll") for (int k = 0; k < 2; ++k) \
        acc[ai][bj][m][n] = __builtin_amdgcn_mfma_f32_16x16x32_bf16(Bt[n][k], At[m][k], acc[ai][bj][m][n], 0, 0, 0); __builtin_amdgcn_s_setprio(0); } while (0)
#define PG8_WAIT_V(n) asm volatile("s_waitcnt vmcnt(" #n ")" ::: "memory")
#define PG8_WAIT_L(n) asm volatile("s_waitcnt lgkmcnt(" #n ")" ::: "memory")
#define PG8_BAR __builtin_amdgcn_s_barrier()
#define PG8_SCHED __builtin_amdgcn_sched_barrier(0)
    Unit cur, nxt; int ui = 0;
    if (!S.next(0, cur)) return;
    f32x4 acc[2][2][4][2];
#pragma unroll
    for (int a = 0; a < 2; ++a)
#pragma unroll
        for (int b = 0; b < 2; ++b)
#pragma unroll
            for (int m = 0; m < 4; ++m)
#pragma unroll
                for (int n = 0; n < 2; ++n) acc[a][b][m][n] = (f32x4){0.f, 0.f, 0.f, 0.f};
    bf16x8 At[4][2], B0[2][2], B1[2][2];
    const char* cA = (const char*)g.A + (size_t)cur.pm * tstep; const char* cB = (const char*)g.Bt + (size_t)cur.pn * tstep;
    S.a_ready(cur);
    if constexpr (SP2) {
        PG8_STAGE(PG8_SB(0, 0), cB, voffB); PG8_STAGE(PG8_SB(0, 1), cB + hstep, voffB); PG8_STAGE(PG8_SA(0, 0), cA, voffA); PG8_STAGE(PG8_SA(0, 1), cA + hstep, voffA);
        if (wr == 1) PG8_BAR;
        PG8_WAIT_V(2); PG8_BAR;
        PG8_STAGE(PG8_SB(1, 0), cB + kstep, voffB); PG8_STAGE(PG8_SA(1, 0), cA + kstep, voffA); PG8_STAGE(PG8_SB(1, 1), cB + hstep + kstep, voffB);
        PG8_WAIT_V(6); PG8_BAR;
    } else {
        PG8_STAGE(PG8_SB(0, 0), cB, voffB); PG8_STAGE(PG8_SA(0, 0), cA, voffA); PG8_STAGE(PG8_SB(0, 1), cB + hstep, voffB); PG8_STAGE(PG8_SA(0, 1), cA + hstep, voffA);
        if (wr == 1) PG8_BAR;
        PG8_WAIT_V(4); PG8_BAR;
        PG8_STAGE(PG8_SB(1, 0), cB + kstep, voffB); PG8_STAGE(PG8_SA(1, 0), cA + kstep, voffA); PG8_STAGE(PG8_SB(1, 1), cB + hstep + kstep, voffB);
        PG8_WAIT_V(6); PG8_BAR;
    }
    for (;;) {
        const bool has_next = S.next(ui + 1, nxt);
        const char* nA = has_next ? (const char*)g.A + (size_t)nxt.pm * tstep : cA; const char* nB = has_next ? (const char*)g.Bt + (size_t)nxt.pn * tstep : cB;
        for (int t = 0; t < nt; t += 2) {
            if constexpr (Epi::HAS_MID) { if (t == nt / 2) E.mid(acc, cur, wr, wc, fr, fq); }
            const bool last = (t == nt - 2);
            const char* a1 = cA + (size_t)(t + 1) * kstep;
            const char* a2 = last ? nA : cA + (size_t)(t + 2) * kstep; const char* b2 = last ? nB : cB + (size_t)(t + 2) * kstep;
            const char* a3 = a2 + kstep; const char* b3 = b2 + kstep;
            if (last && has_next) S.a_ready(nxt);
            if constexpr (SP2) {
            PG8_LDB(B0, 0, 0); PG8_LDB(B1, 0, 1); PG8_SCHED; PG8_LDA(At, 0, 0); PG8_STAGE(PG8_SA(1, 1), a1 + hstep, voffA);
            PG8_WAIT_V(8); PG8_WAIT_L(0); PG8_BAR; PG8_MMA(0, 0, At, B0); PG8_MMA(0, 1, At, B1); PG8_BAR; PG8_SCHED;
            PG8_LDA(At, 0, 1); PG8_STAGE(PG8_SB(0, 0), b2, voffB); PG8_STAGE(PG8_SB(0, 1), b2 + hstep, voffB); PG8_STAGE(PG8_SA(0, 0), a2, voffA);
            PG8_WAIT_V(8); PG8_WAIT_L(0); PG8_BAR; PG8_MMA(1, 0, At, B0); PG8_MMA(1, 1, At, B1); PG8_BAR; PG8_SCHED;
            PG8_LDB(B0, 1, 0); PG8_LDB(B1, 1, 1); PG8_SCHED; PG8_LDA(At, 1, 0); PG8_STAGE(PG8_SA(0, 1), a2 + hstep, voffA);
            PG8_WAIT_V(8); PG8_WAIT_L(0); PG8_BAR; PG8_MMA(0, 0, At, B0); PG8_MMA(0, 1, At, B1); PG8_BAR; PG8_SCHED;
            PG8_LDA(At, 1, 1); PG8_STAGE(PG8_SB(1, 0), b3, voffB); PG8_STAGE(PG8_SB(1, 1), b3 + hstep, voffB); PG8_STAGE(PG8_SA(1, 0), a3, voffA);
            PG8_WAIT_V(8); PG8_WAIT_L(0); PG8_BAR; PG8_MMA(1, 0, At, B0); PG8_MMA(1, 1, At, B1); PG8_BAR; PG8_SCHED;
            } else {
            PG8_LDB(B0, 0, 0); PG8_SCHED; PG8_LDA(At, 0, 0); PG8_STAGE(PG8_SA(1, 1), a1 + hstep, voffA);
            PG8_WAIT_L(8); PG8_BAR; PG8_WAIT_L(0); PG8_MMA(0, 0, At, B0); PG8_BAR; PG8_SCHED;
            PG8_LDB(B1, 0, 1); PG8_STAGE(PG8_SB(0, 0), b2, voffB);
            PG8_BAR; PG8_WAIT_L(0); PG8_MMA(0, 1, At, B1); PG8_BAR;
            PG8_LDA(At, 0, 1); PG8_STAGE(PG8_SA(0, 0), a2, voffA);
            PG8_BAR; PG8_WAIT_L(0); PG8_MMA(1, 0, At, B0); PG8_BAR; PG8_SCHED;
            PG8_STAGE(PG8_SB(0, 1), b2 + hstep, voffB);
            PG8_WAIT_V(6); PG8_BAR; PG8_MMA(1, 1, At, B1); PG8_BAR;
            PG8_LDB(B0, 1, 0); PG8_SCHED; PG8_LDA(At, 1, 0); PG8_STAGE(PG8_SA(0, 1), a2 + hstep, voffA);
            PG8_WAIT_L(8); PG8_BAR; PG8_WAIT_L(0); PG8_MMA(0, 0, At, B0); PG8_BAR; PG8_SCHED;
            PG8_LDB(B1, 1, 1); PG8_STAGE(PG8_SB(1, 0), b3, voffB);
            PG8_BAR; PG8_WAIT_L(0); PG8_MMA(0, 1, At, B1); PG8_BAR;
            PG8_LDA(At, 1, 1); PG8_STAGE(PG8_SA(1, 0), a3, voffA);
            PG8_BAR; PG8_WAIT_L(0); PG8_MMA(1, 0, At, B0); PG8_BAR; PG8_SCHED;
            PG8_STAGE(PG8_SB(1, 1), b3 + hstep, voffB);
            PG8_WAIT_V(6); PG8_BAR; PG8_MMA(1, 1, At, B1); PG8_BAR;
            }
        }
        if constexpr (ALIGN_EPI) { if (wr == 0) PG8_BAR; }
        if constexpr (!Epi::AFTER_DRAIN) { E(acc, cur, wr, wc, fr, fq); S.done(cur); }
        if (!has_next) break;
#pragma unroll
        for (int a = 0; a < 2; ++a)
#pragma unroll
            for (int b = 0; b < 2; ++b)
#pragma unroll
                for (int m = 0; m < 4; ++m)
#pragma unroll
                    for (int n = 0; n < 2; ++n) acc[a][b][m][n] = (f32x4){0.f, 0.f, 0.f, 0.f};
        cur = nxt; cA = nA; cB = nB; ++ui;
        if constexpr (ALIGN_EPI) { if (wr == 1) PG8_BAR; }
    }
    PG8_WAIT_V(0);
    if constexpr (!ALIGN_EPI) { if (wr == 0) PG8_BAR; }
    PG8_BAR;
    if constexpr (Epi::AFTER_DRAIN) { E.fused(acc, cur, wr, wc, fr, fq, lds, wid, lane); S.done(cur); }
#undef PG8_SA
#undef PG8_SB
#undef PG8_STAGE
#undef PG8_LDA
#undef PG8_LDB
#undef PG8_MMA
#undef PG8_WAIT_V
#undef PG8_WAIT_L
#undef PG8_BAR
#undef PG8_SCHED
}
}
#define LAS __attribute__((address_space(3)))
typedef unsigned short bf16;
typedef short bf16x8 __attribute__((ext_vector_type(8)));
typedef short s16x4 __attribute__((ext_vector_type(4)));
typedef float f32x4 __attribute__((ext_vector_type(4)));
typedef float f32x16 __attribute__((ext_vector_type(16)));
typedef unsigned u32x4 __attribute__((ext_vector_type(4)));
typedef unsigned u32x2 __attribute__((ext_vector_type(2)));

constexpr int NB = 4, NT = 2048, ND = 2048, NM = NB * NT;
constexpr int NF = 5632, NUP = 2 * NF;
constexpr int NIN_SRC = 9752, NIN = 9984;
constexpr float EPSF = 1e-6f, LOG2E = 1.4426950408889634f, QSCALE = 0.08838834764831845f * 1.4426950408889634f;
constexpr float LAM_INIT = 0.2f;
constexpr int NWAVES = 8, NTHR = 512;

constexpr size_t MiB = 1u << 20;
constexpr size_t WS_SMALL = 0;
constexpr size_t WS_WUP = 4 * MiB;
constexpr size_t WS_WDOWN = 48 * MiB;
constexpr size_t WS_WO = 70 * MiB;
constexpr size_t WS_WNSA = 78 * MiB;
constexpr size_t WS_WIN = 86 * MiB;
constexpr size_t WS_WC1 = 125 * MiB;
constexpr size_t WS_H = 127 * MiB;
constexpr size_t WS_MIX = 159 * MiB;
constexpr size_t WS_QN = 191 * MiB;
constexpr size_t WS_KV = 207 * MiB;
constexpr size_t WS_DQ = 231 * MiB;
constexpr size_t WS_DK = 247 * MiB;
constexpr size_t WS_DV = 263 * MiB;
constexpr size_t WS_MG = 279 * MiB;
constexpr size_t WS_ONSA = 343 * MiB;
constexpr size_t WS_HF = 375 * MiB;
constexpr size_t WS_HL = 378 * MiB;
constexpr size_t WS_END = 381 * MiB;
constexpr size_t WS_DTMP = 127 * MiB;
constexpr size_t WS_NSATMP = 86 * MiB;
constexpr size_t WS_ACT2 = 191 * MiB;
constexpr size_t SM_MOD = 0;
constexpr size_t SM_LAM = 262144;
constexpr size_t SM_CPART = 266240;
constexpr size_t SM_KC = 524288;
constexpr size_t SM_VC = 786432;
constexpr size_t SM_G = 1048576;
constexpr size_t SM_SLOTS = 2 * MiB;
constexpr size_t SM_BAR = 3 * MiB, SM_QCTR = SM_BAR + 16384, SM_PCNT = SM_QCTR + 1024, SM_BAR_BYTES = 16384 + 1024 + 32 * 256;
static_assert(SM_G + 786432 <= 4 * MiB, "small map");

constexpr int RING_BYTES = 131072;
constexpr int XL_OFF = 131072;
constexpr int LDS_BYTES = 157696;
constexpr int MISC_OFF = LDS_BYTES - 64;
constexpr int A_KBUF = 0, A_VBUF = 49152, A_WSCR = 147456, A_BIAS = 149504;
constexpr int A_IMPP = A_VBUF + 16384, A_IMPP2 = A_VBUF + 32768 + 16384, A_SC = A_VBUF + 65536 + 16384, A_SMASK = A_SC + 8448, A_UN = A_SMASK + 256;
static_assert(A_BIAS + 6528 + 32 <= LDS_BYTES - 64, "lds map");

__device__ const unsigned char T5_BUCKET[128] = {0, 1, 2, 3, 4, 5, 6, 7, 8, 9, 10, 11, 12, 13, 14, 15, 16, 16, 16, 17, 17, 18, 18, 18, 19, 19, 19, 20, 20, 20, 20, 21, 21, 21, 21, 22, 22, 22, 22, 22, 23, 23, 23, 23, 23, 23, 24, 24, 24, 24, 24, 24, 25, 25, 25, 25, 25, 25, 25, 26, 26, 26, 26, 26, 26, 26, 26, 27, 27, 27, 27, 27, 27, 27, 27, 27, 27, 28, 28, 28, 28, 28, 28, 28, 28, 28, 28, 29, 29, 29, 29, 29, 29, 29, 29, 29, 29, 29, 29, 30, 30, 30, 30, 30, 30, 30, 30, 30, 30, 30, 30, 30, 30, 31, 31, 31, 31, 31, 31, 31, 31, 31, 31, 31, 31, 31, 31, 31};

#define LDS_WAIT() asm volatile("s_waitcnt lgkmcnt(0)" ::: "memory")
#define VM_WAIT() asm volatile("s_waitcnt vmcnt(0)" ::: "memory")
__device__ __forceinline__ unsigned f2bf(float f) { unsigned u = __builtin_bit_cast(unsigned, f); return (u + 0x7fffu + ((u >> 16) & 1u)) >> 16; }
__device__ __forceinline__ unsigned pk2(float lo, float hi) { return f2bf(lo) | (f2bf(hi) << 16); }
__device__ __forceinline__ float bf2f(unsigned short h) { return __uint_as_float((unsigned)h << 16); }
__device__ __forceinline__ float wave_sum(float v) {
#pragma unroll
    for (int o = 1; o < 64; o <<= 1) v += __shfl_xor(v, o);
    return v;
}
__device__ __forceinline__ float silu_(float x) { return x / (1.0f + __expf(-x)); }
__device__ __forceinline__ float gelu_tanh_(float x) { const float y = 0.7978845608028654f * (x + 0.044715f * x * x * x); const float t = 1.0f - 2.0f / (__expf(2.0f * y) + 1.0f); return 0.5f * x * (1.0f + t); }

struct Args { const float* in[25]; float* out; unsigned char* ws; int ph_lo, ph_hi; };
typedef const __attribute__((address_space(4))) Args* ArgP;
__device__ __forceinline__ ArgP argp() { ArgP p = (ArgP)__builtin_amdgcn_kernarg_segment_ptr(); asm volatile("" : "+s"(p)); return p; }

__device__ __forceinline__ void p0_transpose_item(const float* W, int K  , int Nsrc, bf16* WT, int k0, int n0, int s0, int nvalid, LAS unsigned* scr, int lane, int kdst = 0  ) {
    const int kq = lane >> 4, nq = lane & 15;
    const bool ok = 4 * nq < nvalid;
    const float* src = W + (size_t)(k0 + 2 * kq) * Nsrc + s0 + 4 * nq;
    f32x4 v[8][2];
#pragma unroll
    for (int i = 0; i < 8; ++i)
#pragma unroll
        for (int h = 0; h < 2; ++h) v[i][h] = ok ? __builtin_nontemporal_load((const f32x4*)(src + (size_t)(8 * i + h) * Nsrc)) : (f32x4){0.f, 0.f, 0.f, 0.f};
#pragma unroll
    for (int i = 0; i < 8; ++i) { const int kp = 4 * i + kq;
#pragma unroll
        for (int e = 0; e < 4; ++e) scr[(4 * nq + e) * 33 + kp] = pk2(v[i][0][e], v[i][1][e]); }
    LDS_WAIT(); asm volatile("" ::: "memory");
    const int c = lane & 7;
#pragma unroll
    for (int j = 0; j < 8; ++j) { const int n = 8 * j + (lane >> 3); const LAS unsigned* s = scr + n * 33 + 4 * c;
        u32x4 o; o.x = s[0]; o.y = s[1]; o.z = s[2]; o.w = s[3];
        __builtin_nontemporal_store(o, (u32x4*)(WT + (size_t)(n0 + n) * K + kdst + k0 + 8 * c)); }
    LDS_WAIT(); asm volatile("" ::: "memory");
}
constexpr int WI_IN = 32 * (NIN / 64), WI_C1 = 64 * 2, WI_UP = 32 * (NUP / 64), WI_DN = (NF / 64) * (ND / 64), WI_O = 32 * 32, WI_NS = 16 * 32;
constexpr int WI_A = WI_IN + 2 * WI_C1, WI_B = WI_UP + WI_DN + WI_O + 2 * WI_NS;
__device__ __forceinline__ void weight_item_a(ArgP a, LAS unsigned* scr, int r, int lane) {
    unsigned char* ws = a->ws;
    if (r < WI_IN) { const int nb = r % (NIN / 64), kb = r / (NIN / 64), n0 = nb * 64; int s0, nv;
        if (n0 < 2560) { s0 = n0; nv = 64; } else if (n0 < 9728) { s0 = n0 + 24; nv = 64; } else if (n0 == 9728) { s0 = 2560; nv = 24; } else { s0 = 0; nv = 0; }
        p0_transpose_item(a->in[6], ND, NIN_SRC, (bf16*)(ws + WS_WIN), kb * 64, n0, s0, nv, scr, lane); return; } r -= WI_IN;
    { const int i = r / WI_C1, rr = r % WI_C1, nb = rr % 2, kb = rr / 2;
      p0_transpose_item(a->in[10] + (size_t)i * 4096 * 128, 4096, 128, (bf16*)(ws + WS_WC1) + (size_t)i * 128 * 4096, kb * 64, nb * 64, nb * 64, 64, scr, lane); }
}
__device__ __forceinline__ void weight_item_b(ArgP a, LAS unsigned* scr, int r, int lane) {
    unsigned char* ws = a->ws;
    if (r < WI_NS) { const int nb = r % 32, kb = r / 32; p0_transpose_item(a->in[17], 2048, ND, (bf16*)(ws + WS_WNSA), kb * 64, nb * 64, nb * 64, 64, scr, lane, 0); return; } r -= WI_NS;
    if (r < WI_NS) { const int nb = r % 32, kb = r / 32; p0_transpose_item(a->in[18], 2048, ND, (bf16*)(ws + WS_WNSA), kb * 64, nb * 64, nb * 64, 64, scr, lane, 1024); return; } r -= WI_NS;
    if (r < WI_O) { const int nb = r % 32, kb = r / 32; p0_transpose_item(a->in[19], ND, ND, (bf16*)(ws + WS_WO), kb * 64, nb * 64, nb * 64, 64, scr, lane); return; } r -= WI_O;
    if (r < WI_UP) { const int nb = r % (NUP / 64), kb = r / (NUP / 64), n0 = nb * 64; const int pn = n0 >> 8, rr = n0 & 255;
        const int s0 = (rr < 128) ? (pn * 128 + rr) : (NF + pn * 128 + rr - 128);
        p0_transpose_item(a->in[20], ND, NUP, (bf16*)(ws + WS_WUP), kb * 64, n0, s0, 64, scr, lane); return; } r -= WI_UP;
    { const int nb = r % (ND / 64), kb = r / (ND / 64); p0_transpose_item(a->in[23], NF, ND, (bf16*)(ws + WS_WDOWN), kb * 64, nb * 64, nb * 64, 64, scr, lane); }
}
__device__ __forceinline__ void p0_weights(ArgP a, LAS unsigned char* lds, int gw, int NGW, int wave, int lane) {
    LAS unsigned* scr = (LAS unsigned*)(lds + wave * 16384);
    for (int it = gw; it < WI_A; it += NGW) weight_item_a(a, scr, it, lane);
}
__device__ __forceinline__ void weights_b_queue(ArgP a, LAS unsigned char* lds, int wave, int lane) {
    LAS unsigned* scr = (LAS unsigned*)(lds + wave * 16384);
    unsigned* ctr = (unsigned*)(a->ws + WS_SMALL + SM_QCTR) + 2;
    for (;;) {
        unsigned c = 0; if (lane == 0) c = __hip_atomic_fetch_add(ctr, 1u, __ATOMIC_RELAXED, __HIP_MEMORY_SCOPE_AGENT);
        const int chunk = __builtin_amdgcn_readfirstlane((int)c);
        if (chunk * 8 >= WI_B) break;
        for (int k = 0; k < 8; ++k) { const int it = chunk * 8 + k; if (it < WI_B) weight_item_b(a, scr, it, lane); }
    }
}
__device__ __forceinline__ void p0_adaln(ArgP a, LAS unsigned char* lds, int tid) {
    LAS float* sc = (LAS float*)lds;
    LAS float* red = (LAS float*)(lds + 32768);
    const float* c = a->in[1]; const float* W = a->in[2]; const float* bias = a->in[3]; float* mod = (float*)(a->ws + WS_SMALL + SM_MOD);
    for (int i = tid; i < 4 * 2048; i += NTHR) sc[i] = silu_(c[i]);
    __syncthreads();
    for (int jb = blockIdx.x; jb < 256; jb += gridDim.x) {
        const int j0 = jb * 48, jq = tid % 12, kg = tid / 12;
        if (kg < 42) {
            f32x4 acc0 = {0, 0, 0, 0}, acc1 = acc0, acc2 = acc0, acc3 = acc0;
#pragma unroll 7
            for (int k = kg; k < 2048; k += 42) {
                const f32x4 w = *(const f32x4*)(W + (size_t)k * 12288 + j0 + jq * 4);
                acc0 += w * sc[k]; acc1 += w * sc[2048 + k]; acc2 += w * sc[4096 + k]; acc3 += w * sc[6144 + k];
            }
            LAS float* rp = red + kg * 192 + jq * 4;
            *(LAS f32x4*)(rp) = acc0; *(LAS f32x4*)(rp + 48) = acc1; *(LAS f32x4*)(rp + 96) = acc2; *(LAS f32x4*)(rp + 144) = acc3;
        }
        __syncthreads();
        if (tid < 192) { float s = 0.f; for (int g = 0; g < 42; ++g) s += red[g * 192 + tid]; const int b = tid / 48, j = j0 + tid % 48; mod[b * 12288 + j] = s + bias[j]; }
        __syncthreads();
    }
}
__device__ __forceinline__ void p0_small(ArgP a, int tid) {
    unsigned char* ws = a->ws;
    if (blockIdx.x == 0 && tid < 64) {
        const float* lq = a->in[14]; const float* lk = a->in[15];
        const float s0 = wave_sum(lq[tid] * lk[tid] + lq[64 + tid] * lk[64 + tid]);
        const float s1 = wave_sum(lq[128 + tid] * lk[128 + tid] + lq[192 + tid] * lk[192 + tid]);
        if (tid == 0) *(float*)(ws + WS_SMALL + SM_LAM) = __expf(s0) - __expf(s1) + LAM_INIT;
    }
    for (int kc = blockIdx.x; kc < 32; kc += gridDim.x) {
        if (tid < 256) { const int i = tid >> 7, n = tid & 127; const float* pe = a->in[9] + i * 4096 + kc * 128; const float* w1 = a->in[10] + ((size_t)i * 4096 + kc * 128) * 128 + n;
            float s = 0.f;
#pragma unroll 8
            for (int k = 0; k < 128; ++k) s += pe[k] * w1[(size_t)k * 128];
            ((float*)(ws + WS_SMALL + SM_CPART))[kc * 256 + tid] = s; }
    }
    { const int g = blockIdx.x * NTHR + tid; if (g < 8 * 128) { const int bg = g >> 7, d = g & 127;
        ((bf16*)(ws + WS_SMALL + SM_KC))[(bg * 128 + 127) * 128 + d] = 0; ((bf16*)(ws + WS_SMALL + SM_VC))[(bg * 128 + 127) * 128 + d] = 0; } }
}

__device__ __forceinline__ void norm_rows(const float* X, const float* gain, const float* sh, const float* scl, bf16* H, int gw, int NGW, int lane) {
    for (int row = gw; row < NM; row += NGW) {
        const int b = row >> 11;
        const f32x4* xr = (const f32x4*)(X + (size_t)row * ND) + lane;
        f32x4 v[8]; float s = 0.f;
#pragma unroll
        for (int j = 0; j < 8; ++j) { v[j] = xr[64 * j]; s += (v[j][0] * v[j][0] + v[j][1] * v[j][1]) + (v[j][2] * v[j][2] + v[j][3] * v[j][3]); }
        const float rs = rsqrtf(wave_sum(s) * (1.0f / ND) + EPSF);
        u32x2* o = (u32x2*)(H + (size_t)row * ND) + lane;
#pragma unroll
        for (int j = 0; j < 8; ++j) { const int c = 256 * j + 4 * lane;
            const f32x4 g = *(const f32x4*)(gain + c), a1 = *(const f32x4*)(scl + b * 12288 + c), a0 = *(const f32x4*)(sh + b * 12288 + c);
            const f32x4 y = v[j] * rs * g * (a1 + 1.0f) + a0;
            u32x2 w; w.x = pk2(y[0], y[1]); w.y = pk2(y[2], y[3]); o[64 * j] = w; }
    }
}

__device__ __forceinline__ void act_fixup(const float* HF, const float* HL, const float* cw, const float* cb, bf16* ACT, int pm, int tid) {
    if ((pm & 7) == 0) return;
    const float* f0 = HF + (size_t)(pm * 2) * NUP; const float* f1 = f0 + NUP;
    const float* l0 = HL + (size_t)((pm - 1) * 2) * NUP; const float* l1 = l0 + NUP;
    for (int j = tid; j < NF; j += NTHR) {
        const int ca = (j >> 7) * 256 + (j & 127), cv = ca + 128;
        const float wa0 = cw[j], wa1 = cw[NUP + j], wa2 = cw[2 * NUP + j], wv0 = cw[NF + j], wv1 = cw[NUP + NF + j], wv2 = cw[2 * NUP + NF + j], ba = cb[j], bv = cb[NF + j];
        const float a_m2 = l0[ca], a_m1 = l1[ca], a_0 = f0[ca], a_1 = f1[ca], v_m2 = l0[cv], v_m1 = l1[cv], v_0 = f0[cv], v_1 = f1[cv];
        const float c0a = ba + wa0 * a_m2 + wa1 * a_m1 + wa2 * a_0, c0v = bv + wv0 * v_m2 + wv1 * v_m1 + wv2 * v_0;
        const float c1a = ba + wa0 * a_m1 + wa1 * a_0 + wa2 * a_1, c1v = bv + wv0 * v_m1 + wv1 * v_0 + wv2 * v_1;
        ACT[(size_t)(pm * 256) * NF + j] = (bf16)f2bf(silu_(c0a) * c0v);
        ACT[(size_t)(pm * 256 + 1) * NF + j] = (bf16)f2bf(silu_(c1a) * c1v);
    }
}
#define XB_TMO      128
#define XB_XCNT(j)  (256  + 64 * (j))
#define XB_XSUB(j)  (1280 + 64 * (j))
#define XB_XGEN(j)  (2304 + 64 * (j))
#define XB_TOP      3328
#define XB_TOPGEN   3392
#define XCD_BAR_WORDS 3456
#define XB_SPIN_CAP (1u << 18)

__device__ __forceinline__ unsigned xb_ld(unsigned* p)              { return __hip_atomic_load(p, __ATOMIC_RELAXED, __HIP_MEMORY_SCOPE_AGENT); }
__device__ __forceinline__ unsigned xb_add(unsigned* p, unsigned v) { return __hip_atomic_fetch_add(p, v, __ATOMIC_RELAXED, __HIP_MEMORY_SCOPE_AGENT); }
__device__ __forceinline__ unsigned xb_xcc_id() { return (unsigned)__builtin_amdgcn_s_getreg((3 << 11) | 20) & 0xFu; }
#define XB_SPIN(cond, bar) do { unsigned _sp = 0; while (cond) { __builtin_amdgcn_s_sleep(1); \
    if ((++_sp & 255u) == 0u) { if (xb_ld(&(bar)[XB_TMO])) break; if (_sp > XB_SPIN_CAP) { atomicAdd(&(bar)[XB_TMO], 1u); break; } } } } while (0)

struct XcdBarrier {
    unsigned* bar; unsigned x;
    volatile LAS unsigned* st;
};

__device__ __forceinline__ XcdBarrier xcd_barrier_post(unsigned* bar, volatile LAS unsigned* st, int tid) {
    XcdBarrier b; b.bar = bar; b.x = xb_xcc_id(); b.st = st;
    if (tid == 0) (void)xb_add(&bar[XB_XCNT(b.x)], 1u);
    return b;
}
__device__ __forceinline__ void xcd_barrier_complete(unsigned* bar, unsigned x, unsigned& nloc, unsigned& nx) {
    const unsigned G = gridDim.x * gridDim.y * gridDim.z;
    unsigned sum, cnt, mine, sp = 0u;
    for (;;) {
        sum = 0u; cnt = 0u; mine = 0u;
#pragma unroll
        for (unsigned j = 0; j < 16; ++j) { const unsigned c = xb_ld(&bar[XB_XCNT(j)]); sum += c; cnt += (c > 0u) ? 1u : 0u; mine = (j == x) ? c : mine; }
        if (sum == G) break;
        __builtin_amdgcn_s_sleep(1);
        if ((++sp & 255u) == 0u) { if (xb_ld(&bar[XB_TMO])) break; if (sp > XB_SPIN_CAP) { atomicAdd(&bar[XB_TMO], 1u); break; } }
    }
    nloc = mine > 0u ? mine : 1u; nx = cnt > 0u ? cnt : 1u;
}

__device__ __forceinline__ void xcd_barrier(const XcdBarrier& b, int tid) {
    asm volatile("s_waitcnt vmcnt(0)" ::: "memory");
    __syncthreads();
    if (tid == 0) {
        unsigned* bar = b.bar;
        __builtin_amdgcn_s_waitcnt(0);
        unsigned nloc = b.st[0], nx = b.st[1];
        if (nloc == 0u) { xcd_barrier_complete(bar, b.x, nloc, nx); b.st[0] = nloc; b.st[1] = nx; }
        const unsigned old = xb_add(&bar[XB_XSUB(b.x)], 1u);
        const unsigned gen = old / nloc;
        if (old + 1u == (gen + 1u) * nloc) {
            __builtin_amdgcn_fence(__ATOMIC_RELEASE, "agent");
            asm volatile("s_waitcnt vmcnt(0)" ::: "memory");
            const unsigned og = xb_add(&bar[XB_TOP], 1u);
            const unsigned tg = og / nx;
            if (og + 1u == (tg + 1u) * nx) xb_add(&bar[XB_TOPGEN], 1u);
            else XB_SPIN(xb_ld(&bar[XB_TOPGEN]) == tg, bar);
            __builtin_amdgcn_fence(__ATOMIC_ACQUIRE, "agent");
            xb_add(&bar[XB_XGEN(b.x)], 1u);
            asm volatile("s_waitcnt vmcnt(0)" ::: "memory");
        } else {
            XB_SPIN(xb_ld(&bar[XB_XGEN(b.x)]) == gen, bar);
            __builtin_amdgcn_fence(__ATOMIC_ACQUIRE, "agent");
            asm volatile("s_waitcnt vmcnt(0)" ::: "memory");
        }
    }
    __syncthreads();
}
namespace att {
constexpr int SHM_K = 16384, SHM_V = 16384;
constexpr float SM_THR = 8.0f;
#define KSWZ(row, colB) ((row) * 256 + ((colB) ^ (((row) & 7) << 4)))
#define SBAR() __builtin_amdgcn_sched_barrier(0)
__device__ __forceinline__ int v_st(int k, int c) { const int kk = (k & ~0xC) | ((k & 4) << 1) | ((k & 8) >> 1); return ((kk >> 3) * 4 + (c >> 5)) * 512 + ((kk & 7) * 32 + (c & 31)) * 2; }
__device__ __forceinline__ int v_rd_base(int lane) { return ((lane & 3) << 3) | (((lane >> 2) & 3) << 6) | (((lane >> 4) & 1) << 5) | (((lane >> 5) & 1) << 8); }
constexpr int v_rd_off(int d0, int ks, int half) { return d0 * 512 + ks * 4096 + half * 2048; }
__device__ __forceinline__ int crow(int r, int hi) { return (r & 3) + 8 * (r >> 2) + 4 * hi; }
__device__ __forceinline__ unsigned cvtpk(float lo, float hi) { unsigned r; asm volatile("v_cvt_pk_bf16_f32 %0, %1, %2" : "=v"(r) : "v"(lo), "v"(hi)); return r; }

__device__ __forceinline__ void qkt(f32x16& p0, f32x16& p1, const LAS char* Kb, int r32, int hi, const bf16x8* qr) {
    p0 = f32x16{}; p1 = f32x16{};
    int ka[4];
#pragma unroll
    for (int dd = 0; dd < 4; ++dd) ka[dd] = (int)(unsigned)(uintptr_t)(Kb + KSWZ(r32, (dd * 16 + hi * 8) * 2));
#define DSR128(dst, addr, off) asm volatile("ds_read_b128 %0, %1 offset:%2" : "=v"(dst) : "v"(addr), "i"(off) : "memory")
    bf16x8 kf[8];
#pragma unroll
    for (int hf = 0; hf < 2; ++hf) {
#pragma unroll
        for (int dd = 0; dd < 4; ++dd) { if (hf == 0) { DSR128(kf[2 * dd], ka[dd], 0); DSR128(kf[2 * dd + 1], ka[dd], 8192); } else { DSR128(kf[2 * dd], ka[dd], 128); DSR128(kf[2 * dd + 1], ka[dd], 8192 + 128); } }
        asm volatile("s_waitcnt lgkmcnt(0)" ::: "memory"); SBAR();
#pragma unroll
        for (int dd = 0; dd < 4; ++dd) {
            p0 = __builtin_amdgcn_mfma_f32_32x32x16_bf16(kf[2 * dd], qr[4 * hf + dd], p0, 0, 0, 0);
            p1 = __builtin_amdgcn_mfma_f32_32x32x16_bf16(kf[2 * dd + 1], qr[4 * hf + dd], p1, 0, 0, 0); }
        SBAR();
    }
#undef DSR128
}
__device__ __forceinline__ void pv_tile(f32x16* o, int vb0, bf16x8 pa0, bf16x8 pa1, bf16x8 pa2, bf16x8 pa3) {
#define TRRD(dst, off) asm volatile("ds_read_b64_tr_b16 %0, %1 offset:%2" : "=&v"(dst) : "v"(vb0), "i"(off) : "memory")
#define PV_RD(S, d0) do { constexpr int b_ = v_rd_off(d0, 0, 0); \
        TRRD(S##l0, b_); TRRD(S##h0, b_ + 2048); TRRD(S##l1, b_ + 4096); TRRD(S##h1, b_ + 6144); TRRD(S##l2, b_ + 8192); TRRD(S##h2, b_ + 10240); TRRD(S##l3, b_ + 12288); TRRD(S##h3, b_ + 14336); } while (0)
#define PV_MM(S, d0) do { \
        o[d0] = __builtin_amdgcn_mfma_f32_32x32x16_bf16(pa0, (bf16x8){S##l0[0], S##l0[1], S##l0[2], S##l0[3], S##h0[0], S##h0[1], S##h0[2], S##h0[3]}, o[d0], 0, 0, 0);   \
        o[d0] = __builtin_amdgcn_mfma_f32_32x32x16_bf16(pa1, (bf16x8){S##l1[0], S##l1[1], S##l1[2], S##l1[3], S##h1[0], S##h1[1], S##h1[2], S##h1[3]}, o[d0], 0, 0, 0);   \
        o[d0] = __builtin_amdgcn_mfma_f32_32x32x16_bf16(pa2, (bf16x8){S##l2[0], S##l2[1], S##l2[2], S##l2[3], S##h2[0], S##h2[1], S##h2[2], S##h2[3]}, o[d0], 0, 0, 0);   \
        o[d0] = __builtin_amdgcn_mfma_f32_32x32x16_bf16(pa3, (bf16x8){S##l3[0], S##l3[1], S##l3[2], S##l3[3], S##h3[0], S##h3[1], S##h3[2], S##h3[3]}, o[d0], 0, 0, 0); } while (0)
#define PV_W8() do { asm volatile("s_waitcnt lgkmcnt(8)" ::: "memory"); SBAR(); } while (0)
#define PV_W0() do { asm volatile("s_waitcnt lgkmcnt(0)" ::: "memory"); SBAR(); } while (0)
    s16x4 Al0, Al1, Al2, Al3, Ah0, Ah1, Ah2, Ah3, Bl0, Bl1, Bl2, Bl3, Bh0, Bh1, Bh2, Bh3;
    PV_RD(A, 0); SBAR(); PV_RD(B, 1); PV_W8(); PV_MM(A, 0); SBAR();
    PV_RD(A, 2); PV_W8(); PV_MM(B, 1); SBAR();
    PV_RD(B, 3); PV_W8(); PV_MM(A, 2); SBAR();
    PV_W0(); PV_MM(B, 3);
#undef PV_RD
#undef PV_MM
#undef PV_W8
#undef PV_W0
#undef TRRD
}
__device__ __forceinline__ void pack_p(const f32x16& p0, const f32x16& p1, bf16x8& pa0, bf16x8& pa1, bf16x8& pa2, bf16x8& pa3) {
#define PK4(P, B_, OUT) do { unsigned a0 = cvtpk(P[B_+0], P[B_+1]), a1 = cvtpk(P[B_+2], P[B_+3]);                          \
        unsigned b0 = cvtpk(P[B_+4], P[B_+5]), b1 = cvtpk(P[B_+6], P[B_+7]);                                             \
        auto r0 = __builtin_amdgcn_permlane32_swap(a0, b0, false, false); auto r1 = __builtin_amdgcn_permlane32_swap(a1, b1, false, false); \
        u32x4 w = {r0[0], r1[0], r0[1], r1[1]}; OUT = *reinterpret_cast<bf16x8*>(&w); } while (0)
    PK4(p0, 0, pa0); PK4(p0, 8, pa1); PK4(p1, 0, pa2); PK4(p1, 8, pa3);
#undef PK4
}
__device__ __forceinline__ float xhalf_max(float v) { auto rr = __builtin_amdgcn_permlane32_swap(__float_as_uint(v), __float_as_uint(v), false, false); return fmaxf(__uint_as_float(rr[0]), __uint_as_float(rr[1])); }
__device__ __forceinline__ float xhalf_sum(float v) { auto rr = __builtin_amdgcn_permlane32_swap(__float_as_uint(v), __float_as_uint(v), false, false); return __uint_as_float(rr[0]) + __uint_as_float(rr[1]); }

template <bool USE_TAB>
__device__ __forceinline__ void xform(f32x16& p0, f32x16& p1, int dq0, unsigned W, bool rowok, float cb, const LAS float* tab  ) {
    const float NEG = -__builtin_inff();
#pragma unroll
    for (int q = 0; q < 4; ++q) {
        const int db0 = dq0 - 8 * q, db1 = db0 - 32;
        float b0[4] = {cb, cb, cb, cb}, b1[4] = {cb, cb, cb, cb};
        if (USE_TAB) {
            const int c0 = db0 < 0 ? 0 : (db0 > 130 ? 130 : db0), c1 = db1 < 0 ? 0 : (db1 > 130 ? 130 : db1);
            const LAS float* t0 = tab + c0; const LAS float* t1 = tab + c1;
#pragma unroll
            for (int e = 0; e < 4; ++e) { b0[e] = t0[3 - e]; b1[e] = t1[3 - e]; asm volatile("" : "+v"(b0[e]), "+v"(b1[e])); }
        }
#pragma unroll
        for (int e = 0; e < 4; ++e) { const int r = 4 * q + e;
            p0[r] = (rowok && (unsigned)(db0 - e) < W) ? p0[r] + b0[e] : NEG;
            p1[r] = (rowok && (unsigned)(db1 - e) < W) ? p1[r] + b1[e] : NEG; }

    }
}
__device__ __forceinline__ void sm_step_c(f32x16& p0, f32x16& p1, float& l, bf16x8& pa0, bf16x8& pa1, bf16x8& pa2, bf16x8& pa3, float off) {
    float ps = 0.f;
#pragma unroll
    for (int r = 0; r < 16; ++r) { p0[r] = __builtin_amdgcn_exp2f(p0[r] + off); p1[r] = __builtin_amdgcn_exp2f(p1[r] + off); ps += p0[r] + p1[r]; }
    ps = xhalf_sum(ps);
    l += ps;
    pack_p(p0, p1, pa0, pa1, pa2, pa3);
}
template <int ND4>
__device__ __forceinline__ void scale_rows(f32x16* o, float f, LAS float* wscr  , int r32, int hi) {
    if (hi == 0) wscr[r32] = f;
    asm volatile("s_waitcnt lgkmcnt(0)" ::: "memory");
    float fr[16];
#pragma unroll
    for (int r = 0; r < 16; ++r) fr[r] = wscr[crow(r, hi)];
#pragma unroll
    for (int d = 0; d < ND4; ++d)
#pragma unroll
        for (int r = 0; r < 16; ++r) o[d][r] *= fr[r];
    asm volatile("s_waitcnt lgkmcnt(0)" ::: "memory");
}
__device__ __forceinline__ int k_dma_off(int wave, int lane, int ldk) { const int row = wave * 4 + (lane >> 4); const int ch = (lane & 15) ^ (row & 7); return row * ldk + ch * 8; }
__device__ __forceinline__ int v_dma_off(int wave, int lane, int ldv) { const int st = wave * 2 + (lane >> 5); const int kk = (st >> 2) * 8 + ((lane & 31) >> 2);
    const int k = (kk & ~0xC) | ((kk & 4) << 1) | ((kk & 8) >> 1); const int c = (st & 3) * 32 + (lane & 3) * 8; return k * ldv + c; }
__device__ __forceinline__ void glds16(const bf16* src, LAS char* dst) { __builtin_amdgcn_global_load_lds((const unsigned*)src, (LAS unsigned*)dst, 16, 0, 0); }
template <int NV>
__device__ __forceinline__ void tile_dma(const bf16* Kt, int ldk, const bf16* Vt, int ldv, int kofs, int vofs, LAS char* Kb, LAS char* Vb, int wave) {
    glds16(Kt + kofs, Kb + wave * 1024); glds16(Kt + kofs + 32 * ldk, Kb + 8192 + wave * 1024);
    glds16(Vt + vofs, Vb + wave * 1024); glds16(Vt + vofs + 32 * ldv, Vb + 8192 + wave * 1024);
    if (NV == 2) { glds16(Vt + 128 + vofs, Vb + SHM_V + wave * 1024); glds16(Vt + 128 + vofs + 32 * ldv, Vb + SHM_V + 8192 + wave * 1024); }
}
struct Stage1 { bf16x8 k0, k1, v0, v1; };
__device__ __forceinline__ void stage_load(Stage1& S, const bf16* Kp, const bf16* Vp, int sr, int sc) {
    S.k0 = *(const bf16x8*)(Kp + sr * 128 + sc); S.k1 = *(const bf16x8*)(Kp + (sr + 32) * 128 + sc);
    S.v0 = *(const bf16x8*)(Vp + sr * 128 + sc); S.v1 = *(const bf16x8*)(Vp + (sr + 32) * 128 + sc);
}
__device__ __forceinline__ void stage_write(const Stage1& S, LAS char* Kb, LAS char* Vb, int kws, int vst0, int vst1) {
    *(LAS bf16x8*)(Kb + kws) = S.k0; *(LAS bf16x8*)(Kb + kws + 32 * 256) = S.k1;
    *(LAS bf16x8*)(Vb + vst0) = S.v0; *(LAS bf16x8*)(Vb + vst1) = S.v1;
}
constexpr int OSTG_BYTES = 32 * 132 * 4;
__device__ __forceinline__ void ostage_write(const f32x16* o, LAS float* wb, int r32, int hi) {
#pragma unroll
    for (int r = 0; r < 16; ++r)
#pragma unroll
        for (int d = 0; d < 4; ++d) wb[crow(r, hi) * 132 + d * 32 + r32] = o[d][r];
    asm volatile("s_waitcnt lgkmcnt(0)" ::: "memory");
}
__device__ __forceinline__ f32x4 ostage_read(const LAS float* wb, int i, int lane) { const int idx = i * 64 + lane; return *(const LAS f32x4*)(wb + (idx >> 5) * 132 + (idx & 31) * 4); }
}

constexpr int BT_STRIDE = 136;
__device__ __forceinline__ float wave_max(float v) {
#pragma unroll
    for (int o = 1; o < 64; o <<= 1) v = fmaxf(v, __shfl_xor(v, o));
    return v;
}
__device__ __forceinline__ void build_bias(ArgP a, LAS float* tab, int tid) {
    const float* rel_bias = a->in[24];
    for (int i = tid; i < 12 * BT_STRIDE; i += NTHR) { const int hd = i / BT_STRIDE, x = i % BT_STRIDE; int d = x - 3; d = d < 0 ? 0 : (d > 127 ? 127 : d); tab[i] = rel_bias[T5_BUCKET[d] * 12 + hd] * LOG2E; }
    if (tid < 64) {
        const float* gq = a->in[7]; const float* gk = a->in[8]; const float* dq = a->in[12]; const float* dk = a->in[13];
        const float mq = wave_max(fmaxf(fabsf(gq[tid]), fabsf(gq[64 + tid]))), mdq = wave_max(fmaxf(fabsf(dq[tid]), fabsf(dq[64 + tid]))), mdk = wave_max(fmaxf(fabsf(dk[tid]), fabsf(dk[64 + tid])));
        const float mk0 = wave_max(fmaxf(fabsf(gk[tid]), fabsf(gk[64 + tid]))), mk1 = wave_max(fmaxf(fabsf(gk[128 + tid]), fabsf(gk[192 + tid]))), mk2 = wave_max(fmaxf(fabsf(gk[256 + tid]), fabsf(gk[320 + tid])));
        float mb = 0.f; for (int i = tid; i < 384; i += 64) mb = fmaxf(mb, fabsf(rel_bias[i])); mb = wave_max(mb) * LOG2E + 1.0f;
        const float K = 1.03f * 128.0f * QSCALE;
        LAS float* cbv = tab + 12 * BT_STRIDE;
        if (tid == 0) { cbv[0] = fminf(K * mdq * mdk + mb, 100.f); cbv[1] = fminf(K * mq * mk0 + mb, 100.f); cbv[2] = fminf(K * mq * mk1 + mb, 100.f); cbv[3] = fminf(K * mq * mk2 + mb, 100.f); }
    }
}

__device__ __forceinline__ void diff_item(ArgP a, LAS unsigned char* lds_g, int item, int tid, int lane, int wave) {
    using namespace att;
    unsigned char* ws = a->ws;
    const int qi = 15 - (item >> 5), rest = item & 31, mp = rest & 1, h = (rest >> 1) & 3, b = rest >> 3;
    const int r32 = lane & 31, hi = lane >> 5, rg = wave >> 1, vh = wave & 1;
    const bf16* DQ = (const bf16*)(ws + WS_DQ); const bf16* DK = (const bf16*)(ws + WS_DK); const bf16* DV = (const bf16*)(ws + WS_DV);
    float* On = (float*)(ws + WS_DTMP) + (size_t)mp * NM * 1024;
    const int tq = qi * 128 + rg * 32 + r32;
    const size_t rowbase = (size_t)b * NT;
    bf16x8 qr[8];
    { const bf16* qp = DQ + ((size_t)(h * 2 + mp) * NM + rowbase + tq) * 128 + hi * 8;
#pragma unroll
      for (int d0 = 0; d0 < 8; ++d0) qr[d0] = *(const bf16x8*)(qp + d0 * 16); }
    const bf16* Kg = DK + ((size_t)(h * 2 + mp) * NM + rowbase) * 128;
    const bf16* Vg = DV + ((size_t)h * NM + rowbase) * 256;
    const int kofs = k_dma_off(wave, lane, 128), vofs = v_dma_off(wave, lane, 256);
    LAS char* L = (LAS char*)lds_g;
    LAS float* wscr = (LAS float*)(L + A_WSCR) + wave * 64;
    const LAS float* tab = (const LAS float*)(L + A_BIAS) + (8 + h) * BT_STRIDE;
    const float cb = tab[130];
    const float CB = ((const LAS float*)(L + A_BIAS))[12 * BT_STRIDE + 0];
    const int vrb = v_rd_base(lane) + vh * SHM_V;
    LAS char* PX = L + A_VBUF + 4 * SHM_V + rg * 4096 + lane * 64;
    f32x16 o[4];
#pragma unroll
    for (int d = 0; d < 4; ++d) o[d] = f32x16{};
    float l = 0.f;
    const int NTI = 2 * qi + 2;
#define DMA_K(t_, s_) do { glds16(Kg + (size_t)(t_) * 64 * 128 + kofs, L + A_KBUF + (s_) * SHM_K + wave * 1024); glds16(Kg + (size_t)(t_) * 64 * 128 + kofs + 32 * 128, L + A_KBUF + (s_) * SHM_K + 8192 + wave * 1024); } while (0)
#define DMA_V(t_, s_) do { const bf16* vt_ = Vg + (size_t)(t_) * 64 * 256 + vofs; LAS char* vb_ = L + A_VBUF + (s_) * 2 * SHM_V + wave * 1024; \
        glds16(vt_, vb_); glds16(vt_ + 32 * 256, vb_ + 8192); glds16(vt_ + 128, vb_ + SHM_V); glds16(vt_ + 128 + 32 * 256, vb_ + SHM_V + 8192); } while (0)
    DMA_K(0, 0); DMA_V(0, 0); DMA_K(1, 1);
#pragma unroll
    for (int d0 = 0; d0 < 8; ++d0) asm volatile("" : "+v"(qr[d0]));
    bf16x8 pk0 = {}, pk1 = {}, pk2 = {}, pk3 = {};
    for (int t = 0; t <= NTI; ++t) {
        if (t == 0) asm volatile("s_waitcnt vmcnt(6)" ::: "memory");
        else if (t + 1 < NTI) asm volatile("s_waitcnt vmcnt(2)" ::: "memory");
        else asm volatile("s_waitcnt vmcnt(0)" ::: "memory");
        __builtin_amdgcn_s_barrier(); asm volatile("" ::: "memory");
        if (t >= 1 && t < NTI) DMA_V(t, t & 1);
        if (t + 2 < NTI) DMA_K(t + 2, (t + 2) % 3);
        const bool prod = (t < NTI) && ((((t + (rg >> 1)) & 1)) == vh);
        const bool prev_mine = (t >= 1) && ((((t - 1 + (rg >> 1)) & 1)) == vh);
        bf16x8 pa0 = pk0, pa1 = pk1, pa2 = pk2, pa3 = pk3;
        if (t >= 1 && !prev_mine) { pa0 = *(const LAS bf16x8*)(PX); pa1 = *(const LAS bf16x8*)(PX + 16); pa2 = *(const LAS bf16x8*)(PX + 32); pa3 = *(const LAS bf16x8*)(PX + 48);
            asm volatile("s_waitcnt lgkmcnt(0)" ::: "memory"); }
        if (prod) {
            f32x16 p0, p1;
            qkt(p0, p1, L + A_KBUF + (t % 3) * SHM_K, r32, hi, qr);
            float cbias = cb;
            if (t >= 2 * qi - 2) { xform<true>(p0, p1, tq - t * 64 - 4 * hi, 0x7fffffffu, true, cb, tab); cbias = 0.f; }
            sm_step_c(p0, p1, l, pk0, pk1, pk2, pk3, cbias - CB);
            *(LAS bf16x8*)(PX) = pk0; *(LAS bf16x8*)(PX + 16) = pk1; *(LAS bf16x8*)(PX + 32) = pk2; *(LAS bf16x8*)(PX + 48) = pk3;
            asm volatile("s_waitcnt lgkmcnt(0)" ::: "memory");
        }
        if (t >= 1) pv_tile(o, (int)(unsigned)(uintptr_t)(L + A_VBUF + ((t - 1) & 1) * 2 * SHM_V) + vrb, pa0, pa1, pa2, pa3);
    }
#undef DMA_K
#undef DMA_V
    if (hi == 0) wscr[32 + r32] = l;
    asm volatile("s_waitcnt lgkmcnt(0)" ::: "memory"); __builtin_amdgcn_s_barrier(); asm volatile("" ::: "memory");
    { const LAS float* pw = (const LAS float*)(L + A_WSCR) + (wave ^ 1) * 64; l += pw[32 + r32]; }
    scale_rows<4>(o, 1.0f / l, wscr, r32, hi);
    unsigned ob = (unsigned)((rowbase + qi * 128 + rg * 32 + 4 * hi) * 1024 + h * 256 + vh * 128 + r32); asm volatile("" : "+v"(ob));
#pragma unroll
    for (int r = 0; r < 16; ++r) { float* rp = On + ((size_t)ob + (unsigned)(((r & 3) + 8 * (r >> 2)) * 1024));
#pragma unroll
        for (int d = 0; d < 4; ++d) rp[d * 32] = o[d][r]; }
}

__device__ __forceinline__ void compress_item(ArgP a, LAS unsigned char* lds_g, int item, int tid, int lane, int wave) {
    unsigned char* ws = a->ws;
    const int i = item >> 5, rb = item & 31;
    const int r32 = lane & 31, hi = lane >> 5, ct = wave & 3, kh = wave >> 2;
    const bf16* KV = (const bf16*)(ws + WS_KV); const bf16* W1T = (const bf16*)(ws + WS_WC1) + (size_t)i * 128 * 4096;
    LAS char* L = (LAS char*)lds_g;
    LAS float* red = (LAS float*)L;
    LAS float* hb = (LAS float*)(L + 16384);
    LAS float* cv = (LAS float*)(L + 32768);
    if (tid < 128) { const float* cp = (const float*)(ws + WS_SMALL + SM_CPART) + i * 128 + tid; float s = 0.f; for (int kc = 0; kc < 32; ++kc) s += cp[kc * 256]; cv[tid] = s; }
    int R = rb * 32 + r32; if (R > 1015) R = 1015;
    const int b = R / 254, rem = R % 254, c = rem >> 1, g = rem & 1;
    const bf16* ap = KV + ((size_t)(i * 2 + g) * NM + (size_t)b * NT + 16 * c + 16 * kh) * 128 + 8 * hi;
    const bf16* bp = W1T + (size_t)(32 * ct + r32) * 4096 + 2048 * kh + 8 * hi;
    f32x16 acc = f32x16{};
#pragma unroll 8
    for (int kk = 0; kk < 128; ++kk) {
        const bf16x8 af = *(const bf16x8*)(ap + (size_t)(kk >> 3) * 128 + (kk & 7) * 16);
        const bf16x8 bf = *(const bf16x8*)(bp + kk * 16);
        acc = __builtin_amdgcn_mfma_f32_32x32x16_bf16(af, bf, acc, 0, 0, 0);
    }
    if (kh == 1) {
#pragma unroll
        for (int r = 0; r < 16; ++r) red[(ct * 16 + r) * 64 + lane] = acc[r]; }
    __syncthreads();
    if (kh == 0) {
#pragma unroll
        for (int r = 0; r < 16; ++r) { const float v = acc[r] + red[(ct * 16 + r) * 64 + lane] + cv[32 * ct + r32];
            hb[att::crow(r, hi) * 128 + 32 * ct + r32] = gelu_tanh_(v); } }
    __syncthreads();
    const int row = tid >> 4, n2 = (tid & 15) * 8;
    const float* w2 = a->in[11] + (size_t)i * 128 * 128 + n2;
    f32x4 s0 = {0, 0, 0, 0}, s1 = s0;
#pragma unroll 4
    for (int n = 0; n < 128; ++n) { const float hv = hb[row * 128 + n]; s0 += *(const f32x4*)(w2 + n * 128) * hv; s1 += *(const f32x4*)(w2 + n * 128 + 4) * hv; }
    if (i == 0) {
        float ss = (s0[0] * s0[0] + s0[1] * s0[1]) + (s0[2] * s0[2] + s0[3] * s0[3]) + (s1[0] * s1[0] + s1[1] * s1[1]) + (s1[2] * s1[2] + s1[3] * s1[3]);
        ss += __shfl_xor(ss, 1); ss += __shfl_xor(ss, 2); ss += __shfl_xor(ss, 4); ss += __shfl_xor(ss, 8);
        const float rs = rsqrtf(ss * (1.0f / 128.0f) + EPSF);
        const f32x4 g0 = *(const f32x4*)(a->in[8] + n2), g1 = *(const f32x4*)(a->in[8] + n2 + 4);
        s0 = s0 * rs * g0; s1 = s1 * rs * g1;
    }
    const int Ro = rb * 32 + row;
    if (Ro < 1016) { const int bo = Ro / 254, remo = Ro % 254, co = remo >> 1, go = remo & 1;
        bf16* dst = (bf16*)(ws + WS_SMALL + (i == 0 ? SM_KC : SM_VC)) + ((size_t)(bo * 2 + go) * 128 + co) * 128 + n2;
        pg8::st8_bf16(dst, s0, s1); }
    __syncthreads();
}

__device__ __forceinline__ void phase3(ArgP a, LAS unsigned char* lds, int tid, int lane, int wave) {
    LAS unsigned char* lds_g = lds;
    build_bias(a, (LAS float*)(lds_g + A_BIAS), tid);
    unsigned* ctr = (unsigned*)(a->ws + WS_SMALL + SM_QCTR);
    volatile LAS unsigned* slot = (volatile LAS unsigned*)(lds_g + MISC_OFF + 16);
    if (tid == 0) slot[0] = __hip_atomic_fetch_add(ctr, 1u, __ATOMIC_RELAXED, __HIP_MEMORY_SCOPE_AGENT);
    __syncthreads();
    int idx = (int)slot[0];
    while (idx < 512 + 64) {
        unsigned nxt = 0;
        if (tid == 0) nxt = __hip_atomic_fetch_add(ctr, 1u, __ATOMIC_RELAXED, __HIP_MEMORY_SCOPE_AGENT);
        if (idx >= 416 && idx < 480) compress_item(a, lds_g, idx - 416, tid, lane, wave);
        else diff_item(a, lds_g, idx < 416 ? idx : idx - 64, tid, lane, wave);
        if (tid == 0) slot[0] = nxt;
        asm volatile("s_waitcnt lgkmcnt(0)" ::: "memory"); __builtin_amdgcn_s_barrier(); asm volatile("" ::: "memory");
        idx = (int)slot[0];
    }
}

#define NSA_SETUP \
    using namespace att; \
    unsigned char* ws = a->ws; \
    int lane = lane_in; asm volatile("" : "+v"(lane)); int tid = tid_in; asm volatile("" : "+v"(tid)); \
    const int ci = 31 - (item & 31), g = (item >> 5) & 1, b = item >> 6; \
    const int r32 = lane & 31, hi = lane >> 5, hh = wave >> 1, hd = g * 4 + hh; \
    const int tl = 32 * (wave & 1) + r32, tq = ci * 64 + tl; \
    const size_t rowbase = (size_t)b * NT; \
    const bf16* QN = (const bf16*)(ws + WS_QN); const bf16* KV = (const bf16*)(ws + WS_KV); \
    const float* Gt = (const float*)(ws + WS_SMALL + SM_G) + (rowbase + tq) * 24 + hd * 3; \
    float* TMP = (float*)(ws + WS_NSATMP); bf16* ONSA = (bf16*)(ws + WS_ONSA); \
    LAS char* L = (LAS char*)lds_g; \
    LAS float* wscr = (LAS float*)(L + A_WSCR) + wave * 64; \
    const LAS float* tab = (const LAS float*)(L + A_BIAS) + hd * BT_STRIDE; \
    const float cb = tab[130]; \
    LAS float* scb = (LAS float*)(L + A_SC); \
    LAS unsigned* smask = (LAS unsigned*)(L + A_SMASK); LAS unsigned* un = (LAS unsigned*)(L + A_UN); \
    const int kofs = k_dma_off(wave, lane, 128), vofs = v_dma_off(wave, lane, 128); \
    const int vrb = v_rd_base(lane); \
    const unsigned obase0 = (unsigned)((rowbase + ci * 64 + 32 * (wave & 1) + 4 * hi) * 1024 + hd * 128 + r32); \
    (void)QN; (void)KV; (void)Gt; (void)TMP; (void)ONSA; (void)wscr; (void)tab; (void)cb; (void)scb; (void)smask; (void)un; (void)kofs; (void)vofs; (void)vrb; (void)obase0; (void)tq; (void)tl; (void)tid;
#define NSA_LOADQ bf16x8 qr[8]; { const bf16* qp = QN + ((size_t)hd * NM + rowbase + tq) * 128 + hi * 8; _Pragma("unroll") for (int d0 = 0; d0 < 8; ++d0) qr[d0] = *(const bf16x8*)(qp + d0 * 16); _Pragma("unroll") for (int d0 = 0; d0 < 8; ++d0) asm volatile("" : "+v"(qr[d0])); }
#define OROW(r) ((size_t)ob + (unsigned)((((r) & 3) + 8 * ((r) >> 2)) * 1024))
#define IMPP(h_, t_) ((LAS float*)(L + ((h_) < 2 ? A_IMPP : A_IMPP2)) + ((((h_) & 1) * 64 + (t_)) * 32))
__device__ __forceinline__ void nsa_b1(ArgP a, LAS unsigned char* lds_g, int item, int tid_in, int lane_in, int wave) {
    NSA_SETUP
    NSA_LOADQ
    f32x16 o[4]; (void)o;
    {
        const bf16* KC = (const bf16*)(ws + WS_SMALL + SM_KC) + (size_t)(b * 2 + g) * 128 * 128;
        const bf16* VC = (const bf16*)(ws + WS_SMALL + SM_VC) + (size_t)(b * 2 + g) * 128 * 128;
        if (tid < 64) smask[tid] = 0u; if (tid == 64) un[0] = 0u;
        { const int kc_ofs = k_dma_off(wave, lane, 128), vc_ofs = v_dma_off(wave, lane, 128);
#pragma unroll
          for (int tt = 0; tt < 2; ++tt) tile_dma<1>(KC + tt * 64 * 128, 128, VC + tt * 64 * 128, 128, kc_ofs, vc_ofs, L + A_KBUF + tt * SHM_K, L + A_VBUF + tt * 2 * SHM_V, wave); }
        __syncthreads();
        f32x16 pA0, pA1, pB0, pB1;
        qkt(pA0, pA1, L + A_KBUF, r32, hi, qr);
        qkt(pB0, pB1, L + A_KBUF + SHM_K, r32, hi, qr);
        const float NEG = -__builtin_inff();
        float pmax = NEG;
#define CMPX(P, coff) { _Pragma("unroll") for (int r = 0; r < 16; ++r) { const int d = tq - 31 - 16 * (crow(r, hi) + (coff)); const int ix = d > 127 ? 127 : (d < 0 ? 0 : d); float bv = tab[ix + 3]; asm volatile("" : "+v"(bv)); P[r] = d >= 0 ? P[r] + bv : NEG; pmax = fmaxf(pmax, P[r]); } }
        CMPX(pA0, 0) CMPX(pA1, 32) CMPX(pB0, 64) CMPX(pB1, 96)
#undef CMPX
        pmax = xhalf_max(pmax);
        const float mm = fmaxf(pmax, -1e30f);
        float ps = 0.f;
#pragma unroll
        for (int r = 0; r < 16; ++r) { pA0[r] = __builtin_amdgcn_exp2f(pA0[r] - mm); pA1[r] = __builtin_amdgcn_exp2f(pA1[r] - mm); pB0[r] = __builtin_amdgcn_exp2f(pB0[r] - mm); pB1[r] = __builtin_amdgcn_exp2f(pB1[r] - mm);
            ps += (pA0[r] + pA1[r]) + (pB0[r] + pB1[r]); }
        ps = xhalf_sum(ps);
        const float inv = ps > 0.f ? 1.0f / ps : 0.f;
#pragma unroll
        for (int r = 0; r < 16; ++r) { pA0[r] *= inv; pA1[r] *= inv; pB0[r] *= inv; pB1[r] *= inv; }
        {
            float dsum[16], p3[16];
#pragma unroll
            for (int q = 0; q < 4; ++q) {
                dsum[0 + q]  = 2.f * (pA0[4 * q] + pA0[4 * q + 1] + pA0[4 * q + 2]) + pA0[4 * q + 3]; p3[0 + q]  = pA0[4 * q + 3];
                dsum[4 + q]  = 2.f * (pA1[4 * q] + pA1[4 * q + 1] + pA1[4 * q + 2]) + pA1[4 * q + 3]; p3[4 + q]  = pA1[4 * q + 3];
                dsum[8 + q]  = 2.f * (pB0[4 * q] + pB0[4 * q + 1] + pB0[4 * q + 2]) + pB0[4 * q + 3]; p3[8 + q]  = pB0[4 * q + 3];
                dsum[12 + q] = 2.f * (pB1[4 * q] + pB1[4 * q + 1] + pB1[4 * q + 2]) + pB1[4 * q + 3]; p3[12 + q] = pB1[4 * q + 3];
            }
            LAS float* ip = IMPP(hh, tl);
#pragma unroll
            for (int G = 0; G < 16; ++G) {
                const float oth = __shfl_xor(p3[G], 32);
                const float othm = G > 0 ? __shfl_xor(p3[G > 0 ? G - 1 : 0], 32) : 0.f;
                ip[2 * G + hi] = dsum[G] + (hi ? oth : othm);
            }
        }
        bf16x8 pa0, pa1, pa2, pa3, pb0, pb1, pb2, pb3;
        pack_p(pA0, pA1, pa0, pa1, pa2, pa3); pack_p(pB0, pB1, pb0, pb1, pb2, pb3);
#pragma unroll
        for (int d = 0; d < 4; ++d) o[d] = f32x16{};
        pv_tile(o, (int)(unsigned)(uintptr_t)(L + A_VBUF) + vrb, pa0, pa1, pa2, pa3);
        pv_tile(o, (int)(unsigned)(uintptr_t)(L + A_VBUF + 2 * SHM_V) + vrb, pb0, pb1, pb2, pb3);
        scale_rows<4>(o, Gt[0], wscr, r32, hi);
        unsigned ob = obase0; asm volatile("" : "+v"(ob));
#pragma unroll
        for (int r = 0; r < 16; ++r) { float* rp = TMP + OROW(r);
#pragma unroll
            for (int d = 0; d < 4; ++d) rp[d * 32] = o[d][r]; }
    }
}
__device__ __forceinline__ void nsa_sel(ArgP a, LAS unsigned char* lds_g, int item, int tid_in, int lane_in, int wave) {
    NSA_SETUP
    f32x16 o[4]; (void)o;
    __syncthreads();
    {
        const int t = tid >> 3, jq = tid & 7;
        float sv[4];
#pragma unroll
        for (int e = 0; e < 4; ++e) { const int j = jq * 4 + e;
            const float imp = (IMPP(0, t)[j] + IMPP(1, t)[j]) + (IMPP(2, t)[j] + IMPP(3, t)[j]);
            const bool forced = (j == 0) || (j == ci) || (j == ci - 1);
            sv[e] = forced ? 1e4f + (float)(32 - j) : (j <= ci ? imp : -1e4f - (float)j);
            scb[t * 33 + j] = sv[e]; }
        __syncthreads();
        float sr[32];
#pragma unroll
        for (int i = 0; i < 32; ++i) sr[i] = scb[t * 33 + i];
        unsigned bits = 0u;
#pragma unroll
        for (int e = 0; e < 4; ++e) { int cnt = 0;
#pragma unroll
            for (int i = 0; i < 32; ++i) cnt += sr[i] > sv[e] ? 1 : 0;
            if (cnt < 16) bits |= 1u << (jq * 4 + e); }
        __hip_atomic_fetch_or(&smask[t], bits, __ATOMIC_RELAXED, __HIP_MEMORY_SCOPE_WORKGROUP); __hip_atomic_fetch_or(&un[0], bits, __ATOMIC_RELAXED, __HIP_MEMORY_SCOPE_WORKGROUP);
        __syncthreads();
    }
}
__device__ __forceinline__ void nsa_b2(ArgP a, LAS unsigned char* lds_g, int item, int tid_in, int lane_in, int wave) {
    NSA_SETUP
    NSA_LOADQ
    f32x16 o[4]; (void)o;
    const unsigned mymask = smask[tl], umask = un[0];
    {
        const bf16* Kg = KV + ((size_t)(2 * 2 + g) * NM + rowbase) * 128;
        const bf16* Vg = KV + ((size_t)(3 * 2 + g) * NM + rowbase) * 128;
#pragma unroll
        for (int d = 0; d < 4; ++d) o[d] = f32x16{};
        float l = 0.f;
        const float CB = ((const LAS float*)(L + A_BIAS))[12 * BT_STRIDE + 2];
        unsigned rem = umask & (ci >= 31 ? 0xffffffffu : ((2u << ci) - 1u));
            int j = rem ? __builtin_ctz(rem) : -1;
        rem &= rem - 1;
        int j1 = rem ? __builtin_ctz(rem) : -1;
        tile_dma<1>(Kg + (size_t)j * 64 * 128, 128, Vg + (size_t)j * 64 * 128, 128, kofs, vofs, L + A_KBUF, L + A_VBUF, wave);
        if (j1 >= 0) { rem &= rem - 1; tile_dma<1>(Kg + (size_t)j1 * 64 * 128, 128, Vg + (size_t)j1 * 64 * 128, 128, kofs, vofs, L + A_KBUF + SHM_K, L + A_VBUF + 2 * SHM_V, wave); }
        int st = 0;
        while (j >= 0) {
            if (j1 >= 0) asm volatile("s_waitcnt vmcnt(4)" ::: "memory"); else asm volatile("s_waitcnt vmcnt(0)" ::: "memory");
            __builtin_amdgcn_s_barrier(); asm volatile("" ::: "memory");
            LAS char* Kb = L + A_KBUF + st * SHM_K; LAS char* Vb = L + A_VBUF + st * 2 * SHM_V;
            const int st2 = st == 0 ? 2 : st - 1;
            int j2 = -1;
            if (rem) { j2 = __builtin_ctz(rem); rem &= rem - 1;
                tile_dma<1>(Kg + (size_t)j2 * 64 * 128, 128, Vg + (size_t)j2 * 64 * 128, 128, kofs, vofs, L + A_KBUF + st2 * SHM_K, L + A_VBUF + st2 * 2 * SHM_V, wave); }
            f32x16 p0, p1;
            qkt(p0, p1, Kb, r32, hi, qr);
            const bool rowok = (mymask >> j) & 1u; float cbias = cb;
            if (j >= ci - 2) { xform<true>(p0, p1, tq - j * 64 - 4 * hi, 0x7fffffffu, rowok, cb, tab); cbias = 0.f; }
            bf16x8 pa0, pa1, pa2, pa3;
            sm_step_c(p0, p1, l, pa0, pa1, pa2, pa3, rowok ? cbias - CB : -__builtin_inff());
            pv_tile(o, (int)(unsigned)(uintptr_t)Vb + vrb, pa0, pa1, pa2, pa3);
            j = j1; j1 = j2; st = st == 2 ? 0 : st + 1;
        }
        __builtin_amdgcn_s_barrier();
        scale_rows<4>(o, l > 0.f ? Gt[1] / l : 0.f, wscr, r32, hi);
        { LAS float* wb = (LAS float*)(L + wave * OSTG_BYTES);
          ostage_write(o, wb, r32, hi);
          unsigned rb = (unsigned)((rowbase + ci * 64 + 32 * (wave & 1)) * 1024 + hd * 128); asm volatile("" : "+v"(rb));
#pragma unroll
          for (int i = 0; i < 16; ++i) { const int idx = i * 64 + lane; float* gp = TMP + ((size_t)rb + (unsigned)((idx >> 5) * 1024 + (idx & 31) * 4));
              *(f32x4*)gp = *(const f32x4*)gp + ostage_read(wb, i, lane); } }
        __syncthreads();
    }
}
__device__ __forceinline__ void nsa_b3(ArgP a, LAS unsigned char* lds_g, int item, int tid_in, int lane_in, int wave) {
    NSA_SETUP
    NSA_LOADQ
    f32x16 o[4]; (void)o;
    {
        const bf16* Kg = KV + ((size_t)(4 * 2 + g) * NM + rowbase) * 128;
        const bf16* Vg = KV + ((size_t)(5 * 2 + g) * NM + rowbase) * 128;
#pragma unroll
        for (int d = 0; d < 4; ++d) o[d] = f32x16{};
        float l = 0.f;
        const float CB = ((const LAS float*)(L + A_BIAS))[12 * BT_STRIDE + 3];
        const int j0 = ci >= 8 ? ci - 8 : 0, NTI = ci - j0 + 1;
        const int sr = tid >> 4, sc = (tid & 15) * 8, vst0 = v_st(sr, sc), vst1 = v_st(32 + sr, sc), kws = KSWZ(sr, sc * 2);
        Stage1 S;
        stage_load(S, Kg + (size_t)j0 * 64 * 128, Vg + (size_t)j0 * 64 * 128, sr, sc);
        stage_write(S, L + A_KBUF, L + A_VBUF, kws, vst0, vst1);
        if (NTI > 1) stage_load(S, Kg + (size_t)(j0 + 1) * 64 * 128, Vg + (size_t)(j0 + 1) * 64 * 128, sr, sc);
        for (int n = 0; n < NTI; ++n) {
            const int j = j0 + n;
            __syncthreads();
            LAS char* Kb = L + A_KBUF + (n & 1) * SHM_K; LAS char* Vb = L + A_VBUF + (n & 1) * 2 * SHM_V;
            if (n + 1 < NTI) { stage_write(S, L + A_KBUF + ((n + 1) & 1) * SHM_K, L + A_VBUF + ((n + 1) & 1) * 2 * SHM_V, kws, vst0, vst1);
                if (n + 2 < NTI) stage_load(S, Kg + (size_t)(j + 2) * 64 * 128, Vg + (size_t)(j + 2) * 64 * 128, sr, sc); }
            f32x16 p0, p1;
            qkt(p0, p1, Kb, r32, hi, qr);
            float cbias = cb;
            if (j >= ci - 2) { xform<true>(p0, p1, tq - j * 64 - 4 * hi, 512u, true, cb, tab); cbias = 0.f; }
            else if (j == ci - 8) { xform<false>(p0, p1, tq - j * 64 - 4 * hi, 512u, true, cb, tab); cbias = 0.f; }
            bf16x8 pa0, pa1, pa2, pa3;
            sm_step_c(p0, p1, l, pa0, pa1, pa2, pa3, cbias - CB);
            pv_tile(o, (int)(unsigned)(uintptr_t)Vb + vrb, pa0, pa1, pa2, pa3);
        }
        __syncthreads();
        scale_rows<4>(o, Gt[2] / l, wscr, r32, hi);
        { LAS float* wb = (LAS float*)(L + wave * OSTG_BYTES);
          ostage_write(o, wb, r32, hi);
          unsigned rb = (unsigned)((rowbase + ci * 64 + 32 * (wave & 1)) * 1024 + hd * 128); asm volatile("" : "+v"(rb));
#pragma unroll
          for (int i = 0; i < 16; ++i) { const int idx = i * 64 + lane; const size_t e = (size_t)rb + (unsigned)((idx >> 5) * 1024 + (idx & 31) * 4);
              const f32x4 v = *(const f32x4*)(TMP + e) + ostage_read(wb, i, lane);
              u32x2 w; w.x = cvtpk(v[0], v[1]); w.y = cvtpk(v[2], v[3]);
              *(u32x2*)(ONSA + e + (e & ~(size_t)1023)) = w; } }
        __syncthreads();
    }
}
__device__ __forceinline__ void nsa_item(ArgP a, LAS unsigned char* lds_g, int item, int tid, int lane, int wave) {
    nsa_b1(a, lds_g, item, tid, lane, wave);
    nsa_sel(a, lds_g, item, tid, lane, wave);
    nsa_b2(a, lds_g, item, tid, lane, wave);
    nsa_b3(a, lds_g, item, tid, lane, wave);
}
#undef NSA_SETUP
#undef NSA_LOADQ
#undef IMPP
#undef OROW
__device__ __forceinline__ void diff_finalize(ArgP a, int gw, int NGW, int lane) {
    unsigned char* ws = a->ws;
    const float lam = *(const float*)(ws + WS_SMALL + SM_LAM);
    const float* D0 = (const float*)(ws + WS_DTMP); const float* D1 = D0 + (size_t)NM * 1024;
    bf16* OD = (bf16*)(ws + WS_ONSA) + 1024;
    const f32x4 gn = *(const f32x4*)(a->in[16] + 4 * lane);
    for (int it = gw; it < NM * 4; it += NGW) {
        const size_t off = (size_t)it * 256 + 4 * lane;
        const f32x4 x0 = *(const f32x4*)(D0 + off), x1 = *(const f32x4*)(D1 + off);
        const f32x4 v = x0 - x1 * lam;
        const float ss = wave_sum((v[0] * v[0] + v[1] * v[1]) + (v[2] * v[2] + v[3] * v[3]));
        const float rs = rsqrtf(ss * (1.0f / 256.0f) + EPSF) * (1.0f - LAM_INIT);
        const f32x4 y = v * rs * gn;
        u32x2 w; w.x = pk2(y[0], y[1]); w.y = pk2(y[2], y[3]);
        *(u32x2*)(OD + off + ((size_t)(it >> 2) << 10)) = w;
    }
}

__device__ __forceinline__ void phase4(ArgP a, LAS unsigned char* lds, int tid, int lane, int wave) {
    LAS unsigned char* lds_g = lds;
    build_bias(a, (LAS float*)(lds_g + A_BIAS), tid);
    __syncthreads();
    for (int it = blockIdx.x; it < 256; it += gridDim.x) nsa_item(a, lds_g, (it & 7) * 32 + (it >> 3), tid, lane, wave);
    diff_finalize(a, blockIdx.x * NWAVES + wave, gridDim.x * NWAVES, lane);
    weights_b_queue(a, lds_g, wave, lane);
}
#ifndef ONE_LAUNCH
#define ONE_LAUNCH 0
#endif
constexpr int N_PHASES = 11;
__global__ void __launch_bounds__(NTHR, 2) mk_fwd(Args a) {
    extern __shared__ __attribute__((aligned(16))) unsigned char lds_raw[];
    LAS unsigned char* lds = (LAS unsigned char*)lds_raw;
    const int wave0 = __builtin_amdgcn_readfirstlane(threadIdx.x >> 6);
    const int lo = a.ph_lo, hi = a.ph_hi;
#define MK_TID(t_) int t_; { int w_ = wave0; asm volatile("" : "+s"(w_)); int l_; asm volatile("v_mbcnt_lo_u32_b32 %0, -1, 0\n\tv_mbcnt_hi_u32_b32 %0, -1, %0" : "=v"(l_)); t_ = w_ * 64 + l_; }
#if ONE_LAUNCH
    XcdBarrier bar;
    { MK_TID(t0_) if (t0_ < 16) ((volatile LAS unsigned*)(lds + MISC_OFF))[t0_] = 0u; __syncthreads();
      ArgP ap0 = argp(); bar = xcd_barrier_post((unsigned*)(ap0->ws + WS_SMALL + SM_BAR), (volatile LAS unsigned*)(lds + MISC_OFF), t0_);
    }
#define SEAM(k) do { if (lo <= (k) && (k) + 1 < hi) { MK_TID(ts_) xcd_barrier(bar, ts_); } } while (0)
#else
#define SEAM(k) do { } while (0)
#endif
#define IN(k) (lo <= (k) && (k) < hi)
#define PH_BEGIN ArgP ap = argp(); unsigned char* ws = ap->ws; float* mod = (float*)(ws + WS_SMALL + SM_MOD); (void)mod; \
    int wave = wave0; asm volatile("" : "+s"(wave)); int lane; asm volatile("v_mbcnt_lo_u32_b32 %0, -1, 0\n\tv_mbcnt_hi_u32_b32 %0, -1, %0" : "=v"(lane)); \
    const int tid = wave * 64 + lane, G = gridDim.x, gw = blockIdx.x * NWAVES + wave, NGW = G * NWAVES, gtid = blockIdx.x * NTHR + tid, NGT = G * NTHR; (void)gw; (void)NGW; (void)gtid; (void)NGT; (void)G;

    if (IN(0)) { PH_BEGIN p0_adaln(ap, lds, tid); p0_small(ap, tid); __syncthreads(); p0_weights(ap, lds, gw, NGW, wave, lane); }
    SEAM(0);
    if (IN(1)) { PH_BEGIN norm_rows(ap->in[0], ap->in[4], mod + 0, mod + 2048, (bf16*)(ws + WS_H), gw, NGW, lane); }
    SEAM(1);
    if (IN(2)) { PH_BEGIN
        pg8::Gemm g{(const bf16*)(ws + WS_H), (const bf16*)(ws + WS_WIN), NM, NIN, ND}; pg8::StaticOrder S; S.init(NM, NIN, G, (int)blockIdx.x);
        pg8::EpiInProj E{(bf16*)(ws + WS_QN), (bf16*)(ws + WS_KV), (bf16*)(ws + WS_DQ), (bf16*)(ws + WS_DK), (bf16*)(ws + WS_DV), (bf16*)(ws + WS_MG), (float*)(ws + WS_SMALL + SM_G),
                          ap->in[7], ap->in[8], ap->in[12], ap->in[13], (LAS float*)(lds + XL_OFF), QSCALE, EPSF};
        pg8::gemm_phase<pg8::EpiInProj, pg8::StaticOrder, true, true>(lds, g, S, E, tid, wave, lane);
    }
    SEAM(2);
    if (IN(3)) { PH_BEGIN phase3(ap, lds, tid, lane, wave); }
    SEAM(3);
    if (IN(4)) { PH_BEGIN phase4(ap, lds, tid, lane, wave); }
    SEAM(4);
    if (IN(5)) { PH_BEGIN
        pg8::Gemm g{(const bf16*)(ws + WS_ONSA), (const bf16*)(ws + WS_WNSA), NM, ND, 2048}; pg8::StaticOrder S; S.init(NM, ND, G, (int)blockIdx.x);
        pg8::EpiMix E{(const bf16*)(ws + WS_MG), (bf16*)(ws + WS_MIX)};
        pg8::gemm_phase<pg8::EpiMix, pg8::StaticOrder, true, true>(lds, g, S, E, tid, wave, lane);
    }
    SEAM(5);
    if (IN(6)) { PH_BEGIN
        pg8::Gemm g{(const bf16*)(ws + WS_MIX), (const bf16*)(ws + WS_WO), NM, ND, ND}; pg8::StaticOrder S; S.init(NM, ND, G, (int)blockIdx.x);
        if (G == 256) {
            pg8::EpiResidNorm E{ap->in[0], mod + 4096, 12288, ap->out, (bf16*)(ws + WS_H), ap->in[5], mod + 8192, mod + 6144,
                                (unsigned*)(ws + WS_SMALL + SM_SLOTS), (unsigned*)(ws + WS_SMALL + SM_PCNT), EPSF};
            pg8::gemm_phase<pg8::EpiResidNorm, pg8::StaticOrder, false, true>(lds, g, S, E, tid, wave, lane);
        } else {
            pg8::EpiResid E{ap->in[0], mod + 4096, 12288, ap->out};
            pg8::gemm_phase<pg8::EpiResid, pg8::StaticOrder, true, true>(lds, g, S, E, tid, wave, lane);
        }
    }
    SEAM(6);
    if (IN(7) && gridDim.x != 256) { PH_BEGIN norm_rows(ap->out, ap->in[5], mod + 6144, mod + 8192, (bf16*)(ws + WS_H), gw, NGW, lane); }
    if (gridDim.x != 256) SEAM(7);
    if (IN(8)) { PH_BEGIN
        pg8::Gemm g{(const bf16*)(ws + WS_H), (const bf16*)(ws + WS_WUP), NM, NUP, ND}; pg8::StaticOrder S; S.init(NM, NUP, G, (int)blockIdx.x);
        pg8::EpiUpAct E{(bf16*)(ws + WS_ACT2), ap->in[21], ap->in[22], (float*)(ws + WS_HF), (float*)(ws + WS_HL), (LAS float*)(lds + XL_OFF), NF, NUP};
        pg8::gemm_phase<pg8::EpiUpAct, pg8::StaticOrder, true, true>(lds, g, S, E, tid, wave, lane);
    }
    SEAM(8);
    if (IN(10)) { PH_BEGIN
        pg8::Gemm g{(const bf16*)(ws + WS_ACT2), (const bf16*)(ws + WS_WDOWN), NM, ND, NF}; pg8::StaticOrder S; S.init(NM, ND, G, (int)blockIdx.x);
        { pg8::Unit u0; for (int i = 0; S.next(i, u0); ++i) act_fixup((const float*)(ws + WS_HF), (const float*)(ws + WS_HL), ap->in[21], ap->in[22], (bf16*)(ws + WS_ACT2), u0.pm, tid);
          asm volatile("s_waitcnt vmcnt(0)" ::: "memory"); __syncthreads(); }
        pg8::EpiResid E{ap->out, mod + 10240, 12288, ap->out};
        pg8::gemm_phase<pg8::EpiResid, pg8::StaticOrder, true, true>(lds, g, S, E, tid, wave, lane);
    }
#undef IN
#undef PH_BEGIN
#undef SEAM
}

extern "C" void kernel_launch(void* const* d_in, const int* in_sizes, int n_in, void* d_out, int out_size, void* d_ws, size_t ws_size, hipStream_t stream) {
    static int grid = 0;
    if (grid == 0) {
        if (n_in != 25 || out_size != NM * ND || ws_size < WS_END) { fprintf(stderr, "kernel_launch: unexpected shapes (n_in %d out %d ws %zu)\n", n_in, out_size, ws_size); grid = -1; return; }
        int dev = 0, cus = 0, per_cu = 0;
        (void)hipGetDevice(&dev); (void)hipDeviceGetAttribute(&cus, hipDeviceAttributeMultiprocessorCount, dev);
        if (hipFuncSetAttribute((const void*)mk_fwd, hipFuncAttributeMaxDynamicSharedMemorySize, LDS_BYTES) != hipSuccess) { fprintf(stderr, "kernel_launch: hipFuncSetAttribute failed\n"); grid = -1; return; }
        if (hipOccupancyMaxActiveBlocksPerMultiprocessor(&per_cu, (const void*)mk_fwd, NTHR, LDS_BYTES) != hipSuccess || per_cu < 1) { fprintf(stderr, "kernel_launch: occupancy query says %d\n", per_cu); per_cu = 1; }
        (void)hipGetLastError();
        grid = cus < 256 ? cus : 256;
    }
    if (grid < 0) return;
    Args a{};
    for (int i = 0; i < 25; ++i) a.in[i] = (const float*)d_in[i];
    a.out = (float*)d_out; a.ws = (unsigned char*)d_ws;
    (void)hipMemsetAsync((char*)d_ws + WS_SMALL + SM_BAR, 0, SM_BAR_BYTES, stream);
#if ONE_LAUNCH
    a.ph_lo = 0; a.ph_hi = N_PHASES;
    void* args[] = {&a};
    hipError_t e = hipLaunchCooperativeKernel((const void*)mk_fwd, dim3(grid), dim3(NTHR), args, LDS_BYTES, stream);
    if (e != hipSuccess) fprintf(stderr, "cooperative launch failed: %s (grid %d)\n", hipGetErrorString(e), grid);
#else
    for (int p = 0; p < N_PHASES; ++p) {
        if (p == 9) continue;
        a.ph_lo = p; a.ph_hi = p + 1;
        hipLaunchKernelGGL(mk_fwd, dim3(grid), dim3(NTHR), LDS_BYTES, stream, a);
    }
#endif
}
```
